# Optimizing an MI355X kernel written in HIP

```python
import math
import jax, jax.numpy as jnp
from jax import lax
import numpy as np

D_MODEL = 1024
BATCH = 8
SEQ = 2048
DEPTH = 2
DEC_BATCH = 128
DEC_SEQ = 8
PAST_LEN = 16384
PAGE_SIZE = 128

D_INNER = 2 * D_MODEL
SSD_HEAD_DIM = 64
SSD_HEADS = D_INNER // SSD_HEAD_DIM
SSD_GROUPS = 8
SSD_HPG = SSD_HEADS // SSD_GROUPS
D_STATE = 128
CONV_W = 4
CONV_DIM = D_INNER + 2 * SSD_GROUPS * D_STATE
SSD_IN_DIM = D_INNER + CONV_DIM + SSD_HEADS
CHUNK = 128
POOL_WINDOWS = (2, 4, 8, 16)
N_POOL_GROUPS = len(POOL_WINDOWS)
D_POOL = D_MODEL
POOL_GROUP_DIM = D_POOL // N_POOL_GROUPS
MAX_WIN = max(POOL_WINDOWS)
D_FF = 2816
N_SSD_LAYERS = (DEPTH + 1) // 2
N_POOL_LAYERS = DEPTH // 2
EPS = 1e-6

kernel_name = 'ssd_pool_macaron_decode'


def rmsnorm(x, g):
    xf = x.astype(jnp.float32)
    y = xf * lax.rsqrt(jnp.mean(xf * xf, axis=-1, keepdims=True) + EPS)
    return (y * g.astype(jnp.float32)).astype(x.dtype)


def swiglu(h, w_gate, w_up, w_down):
    return (jax.nn.silu(h @ w_gate) * (h @ w_up)) @ w_down


def causal_dwconv(u, buf, w, b):
    l = u.shape[1]
    ext = jnp.concatenate([buf.astype(u.dtype), u], axis=1)
    y = b
    for k in range(CONV_W):
        y = y + ext[:, k:k + l] * w[k]
    return y, ext[:, l:]


def ssd_scan(x, dt, A, Bm, Cm, h0):
    f32 = jnp.float32
    bsz, l = x.shape[:2]
    q = min(CHUNK, l)
    nc = -(-l // q)
    pad = nc * q - l
    if pad:
        padw = lambda a: jnp.pad(a, [(0, 0), (0, pad)] + [(0, 0)] * (a.ndim - 2))
        x, dt, Bm, Cm = padw(x), padw(dt), padw(Bm), padw(Cm)
    xc = x.reshape(bsz, nc, q, SSD_GROUPS, SSD_HPG, SSD_HEAD_DIM).astype(f32)
    dtc = dt.reshape(bsz, nc, q, SSD_GROUPS, SSD_HPG).astype(f32)
    Bc = Bm.reshape(bsz, nc, q, SSD_GROUPS, D_STATE).astype(f32)
    Cc = Cm.reshape(bsz, nc, q, SSD_GROUPS, D_STATE).astype(f32)
    a_cum = jnp.cumsum(dtc * A.reshape(SSD_GROUPS, SSD_HPG), axis=2)
    seg = a_cum[:, :, :, None] - a_cum[:, :, None]
    tril = jnp.tril(jnp.ones((q, q), dtype=bool))[:, :, None, None]
    decay = jnp.exp(jnp.where(tril, seg, -jnp.inf))
    xdt = xc * dtc[..., None]
    cb = jnp.einsum('bclgn,bcsgn->bclsg', Cc, Bc)
    y_diag = jnp.einsum('bclsgr,bcsgrp->bclgrp', cb[..., None] * decay, xdt)
    decay_end = jnp.exp(a_cum[:, :, -1:] - a_cum)
    chunk_states = jnp.einsum('bcsgn,bcsgr,bcsgrp->bcgrpn', Bc, decay_end, xdt)
    chunk_decay = jnp.exp(a_cum[:, :, -1])

    def step(h, inp):
        st, dec = inp
        return h * dec[..., None, None] + st, h

    h_init = h0.reshape(bsz, SSD_GROUPS, SSD_HPG, SSD_HEAD_DIM, D_STATE).astype(f32)
    h_final, h_starts = lax.scan(step, h_init,
                                 (jnp.moveaxis(chunk_states, 1, 0), jnp.moveaxis(chunk_decay, 1, 0)))
    h_starts = jnp.moveaxis(h_starts, 0, 1)
    y_off = jnp.einsum('bclgn,bclgr,bcgrpn->bclgrp', Cc, jnp.exp(a_cum), h_starts)
    y = (y_diag + y_off).reshape(bsz, nc * q, SSD_HEADS, SSD_HEAD_DIM)[:, :l]
    return y, h_final.reshape(bsz, SSD_HEADS, SSD_HEAD_DIM, D_STATE)


def ssd_mixer(h, ssm0, conv0, w_in, conv_w, conv_b, dt_bias, a_log, d_skip, norm_g, w_out):
    f32 = jnp.float32
    bsz, l, _ = h.shape
    proj = h @ w_in
    z, xbc, dt_raw = jnp.split(proj, [D_INNER, D_INNER + CONV_DIM], axis=-1)
    xbc, conv_new = causal_dwconv(xbc, conv0, conv_w, conv_b)
    xbc = jax.nn.silu(xbc)
    xs, Bm, Cm = jnp.split(xbc, [D_INNER, D_INNER + SSD_GROUPS * D_STATE], axis=-1)
    xs = xs.reshape(bsz, l, SSD_HEADS, SSD_HEAD_DIM)
    Bm = Bm.reshape(bsz, l, SSD_GROUPS, D_STATE)
    Cm = Cm.reshape(bsz, l, SSD_GROUPS, D_STATE)
    dt = jax.nn.softplus((dt_raw + dt_bias).astype(f32))
    A = -jnp.exp(a_log.astype(f32))
    y, ssm_new = ssd_scan(xs, dt, A, Bm, Cm, ssm0)
    y = y + d_skip.astype(f32)[:, None] * xs.astype(f32)
    y = y.reshape(bsz, l, D_INNER) * jax.nn.silu(z.astype(f32))
    yg = y.reshape(bsz, l, SSD_GROUPS, D_INNER // SSD_GROUPS)
    yg = yg * lax.rsqrt(jnp.mean(yg * yg, axis=-1, keepdims=True) + EPS)
    y = (yg.reshape(bsz, l, D_INNER) * norm_g.astype(f32)).astype(h.dtype)
    return y @ w_out, ssm_new.astype(ssm0.dtype), conv_new.astype(conv0.dtype)


def pool_mixer(h, buf, pos0, w_in, w_group, scale, w_out):
    f32 = jnp.float32
    bsz, l, _ = h.shape
    u = h @ w_in
    ext = jnp.concatenate([buf.astype(u.dtype), u], axis=1)
    cs = jnp.cumsum(ext.astype(f32), axis=1)
    cs = jnp.concatenate([jnp.zeros((bsz, 1, D_POOL), f32), cs], axis=1)
    end = cs[:, MAX_WIN:MAX_WIN + l]
    pos = (pos0 + jnp.arange(l)).astype(f32)
    outs = []
    for k, w in enumerate(POOL_WINDOWS):
        sl = slice(k * POOL_GROUP_DIM, (k + 1) * POOL_GROUP_DIM)
        count = jnp.minimum(jnp.float32(w), pos + 1.0)[None, :, None]
        mean = (end[..., sl] - cs[:, MAX_WIN - w:MAX_WIN - w + l, sl]) / count
        outs.append(mean - u[..., sl].astype(f32))
    mixed = jnp.stack(outs, axis=2).astype(u.dtype)
    mixed = jnp.einsum('blgc,gcd->blgd', mixed, w_group).reshape(bsz, l, D_POOL)
    return (mixed * scale) @ w_out, ext[:, l:].astype(buf.dtype)


def trunk(x, ssm_st, conv_st, pool_st, pos0,
          ffn_norm, ffn_w_gate, ffn_w_up, ffn_w_down, mix_norm,
          ssd_w_in, ssd_conv_w, ssd_conv_b, ssd_dt_bias, ssd_a_log, ssd_d, ssd_norm, ssd_w_out,
          pool_w_in, pool_w_group, pool_scale, pool_w_out, final_norm):
    new_ssm, new_conv, new_pool = [], [], []
    for i in range(DEPTH):
        x = x + 0.5 * swiglu(rmsnorm(x, ffn_norm[i, 0]), ffn_w_gate[i, 0], ffn_w_up[i, 0], ffn_w_down[i, 0])
        h = rmsnorm(x, mix_norm[i])
        j = i // 2
        if i % 2 == 0:
            m, s_new, c_new = ssd_mixer(h, ssm_st[j], conv_st[j], ssd_w_in[j], ssd_conv_w[j], ssd_conv_b[j],
                                        ssd_dt_bias[j], ssd_a_log[j], ssd_d[j], ssd_norm[j], ssd_w_out[j])
            new_ssm.append(s_new)
            new_conv.append(c_new)
        else:
            m, p_new = pool_mixer(h, pool_st[j], pos0, pool_w_in[j], pool_w_group[j], pool_scale[j], pool_w_out[j])
            new_pool.append(p_new)
        x = x + m
        x = x + 0.5 * swiglu(rmsnorm(x, ffn_norm[i, 1]), ffn_w_gate[i, 1], ffn_w_up[i, 1], ffn_w_down[i, 1])
    return rmsnorm(x, final_norm), jnp.stack(new_ssm), jnp.stack(new_conv), jnp.stack(new_pool)


def setup_inputs(seed: int = 0) -> dict:
    key = jax.random.key(seed)
    ks = jax.random.split(key, 24)
    f32 = jnp.float32

    def nrm(k, shape, scale):
        return jax.random.normal(k, shape, f32) * scale

    dt0 = jnp.exp(jax.random.uniform(ks[13], (N_SSD_LAYERS, SSD_HEADS), f32, math.log(1e-3), math.log(0.1)))
    return {
        'x_prompt': nrm(ks[0], (BATCH, SEQ, D_MODEL), 1.0),
        'x_sample': nrm(ks[1], (DEC_BATCH, DEC_SEQ, D_MODEL), 1.0),
        'state_ssm': nrm(ks[2], (N_SSD_LAYERS, DEC_BATCH, SSD_HEADS, SSD_HEAD_DIM, D_STATE), 0.1),
        'state_conv': nrm(ks[3], (N_SSD_LAYERS, DEC_BATCH, CONV_W - 1, CONV_DIM), 1.0),
        'state_pool': nrm(ks[4], (N_POOL_LAYERS, DEC_BATCH, MAX_WIN - 1, D_POOL), 1.0),
        'ffn_norm': 1.0 + nrm(ks[5], (DEPTH, 2, D_MODEL), 0.02),
        'ffn_w_gate': nrm(ks[6], (DEPTH, 2, D_MODEL, D_FF), D_MODEL ** -0.5),
        'ffn_w_up': nrm(ks[7], (DEPTH, 2, D_MODEL, D_FF), D_MODEL ** -0.5),
        'ffn_w_down': nrm(ks[8], (DEPTH, 2, D_FF, D_MODEL), D_FF ** -0.5),
        'mix_norm': 1.0 + nrm(ks[9], (DEPTH, D_MODEL), 0.02),
        'ssd_w_in': nrm(ks[10], (N_SSD_LAYERS, D_MODEL, SSD_IN_DIM), D_MODEL ** -0.5),
        'ssd_conv_w': nrm(ks[11], (N_SSD_LAYERS, CONV_W, CONV_DIM), CONV_W ** -0.5),
        'ssd_conv_b': nrm(ks[12], (N_SSD_LAYERS, CONV_DIM), 0.02),
        'ssd_dt_bias': dt0 + jnp.log(-jnp.expm1(-dt0)),
        'ssd_a_log': jnp.log(jax.random.uniform(ks[14], (N_SSD_LAYERS, SSD_HEADS), f32, 1.0, 16.0)),
        'ssd_d': 1.0 + nrm(ks[15], (N_SSD_LAYERS, SSD_HEADS), 0.1),
        'ssd_norm': 1.0 + nrm(ks[16], (N_SSD_LAYERS, D_INNER), 0.02),
        'ssd_w_out': nrm(ks[17], (N_SSD_LAYERS, D_INNER, D_MODEL), D_INNER ** -0.5),
        'pool_w_in': nrm(ks[18], (N_POOL_LAYERS, D_MODEL, D_POOL), D_MODEL ** -0.5),
        'pool_w_group': nrm(ks[19], (N_POOL_LAYERS, N_POOL_GROUPS, POOL_GROUP_DIM, POOL_GROUP_DIM), POOL_GROUP_DIM ** -0.5),
        'pool_scale': 1.0 + nrm(ks[20], (N_POOL_LAYERS, D_POOL), 0.1),
        'pool_w_out': nrm(ks[21], (N_POOL_LAYERS, D_POOL, D_MODEL), D_POOL ** -0.5),
        'final_norm': 1.0 + nrm(ks[22], (D_MODEL,), 0.02),
    }


def reference(x_prompt, x_sample, state_ssm, state_conv, state_pool,
              ffn_norm, ffn_w_gate, ffn_w_up, ffn_w_down, mix_norm,
              ssd_w_in, ssd_conv_w, ssd_conv_b, ssd_dt_bias, ssd_a_log, ssd_d, ssd_norm, ssd_w_out,
              pool_w_in, pool_w_group, pool_scale, pool_w_out, final_norm):
    bp = x_prompt.shape[0]
    ssm0 = jnp.zeros((N_SSD_LAYERS, bp, SSD_HEADS, SSD_HEAD_DIM, D_STATE), state_ssm.dtype)
    conv0 = jnp.zeros((N_SSD_LAYERS, bp, CONV_W - 1, CONV_DIM), state_conv.dtype)
    pool0 = jnp.zeros((N_POOL_LAYERS, bp, MAX_WIN - 1, D_POOL), state_pool.dtype)
    y_prompt, ssm_p, conv_p, pool_p = trunk(
        x_prompt, ssm0, conv0, pool0, 0,
        ffn_norm, ffn_w_gate, ffn_w_up, ffn_w_down, mix_norm,
        ssd_w_in, ssd_conv_w, ssd_conv_b, ssd_dt_bias, ssd_a_log, ssd_d, ssd_norm, ssd_w_out,
        pool_w_in, pool_w_group, pool_scale, pool_w_out, final_norm)
    y_sample, ssm_s, conv_s, pool_s = trunk(
        x_sample, state_ssm, state_conv, state_pool, PAST_LEN,
        ffn_norm, ffn_w_gate, ffn_w_up, ffn_w_down, mix_norm,
        ssd_w_in, ssd_conv_w, ssd_conv_b, ssd_dt_bias, ssd_a_log, ssd_d, ssd_norm, ssd_w_out,
        pool_w_in, pool_w_group, pool_scale, pool_w_out, final_norm)
    return (y_prompt, y_sample, ssm_p, conv_p, pool_p, ssm_s, conv_s, pool_s)
```

```cpp
#include <hip/hip_runtime.h>
#include <hip/hip_cooperative_groups.h>
#include <cstdio>
namespace cg = cooperative_groups;

#define LAS __attribute__((address_space(3)))
typedef unsigned short bf16_t;
typedef short bf16x8 __attribute__((ext_vector_type(8)));
typedef float f32x4 __attribute__((ext_vector_type(4)));
typedef unsigned u32x4 __attribute__((ext_vector_type(4)));
typedef unsigned u32x2 __attribute__((ext_vector_type(2)));

constexpr int MP = 16384, MS = 1024, MT = MP + MS;
constexpr int DM = 1024, FF = 2816, DI = 2048, NPROJ = 6144, NINP = 6400, NIN = 6176;
constexpr float EPS = 1e-6f;
constexpr int NTHR = 512;
constexpr int LDS_BYTES = 131072;

constexpr size_t WS_WGU = 0;
constexpr size_t WS_WD = WS_WGU + (size_t)4 * 5632 * 1024 * 2;
constexpr size_t WS_WIN = WS_WD + (size_t)4 * 1024 * 2816 * 2;
constexpr size_t WS_WOUT = WS_WIN + (size_t)NINP * 1024 * 2;
constexpr size_t WS_WPIN = WS_WOUT + (size_t)1024 * 2048 * 2;
constexpr size_t WS_WPG = WS_WPIN + (size_t)1024 * 1024 * 2;
constexpr size_t WS_WPOUT = WS_WPG + (size_t)1024 * 256 * 2;
constexpr size_t WS_XRES = WS_WPOUT + (size_t)1024 * 1024 * 2;
constexpr size_t WS_XB = WS_XRES + (size_t)MT * 1024 * 4;
constexpr size_t WS_SSQ = WS_XB + (size_t)MT * 1024 * 2;
constexpr size_t WS_YSS = WS_SSQ + (size_t)MT * 16 * 4;
constexpr size_t WS_DT = WS_YSS + (size_t)MT * 64 * 4;
constexpr size_t WS_YG = WS_DT + (size_t)MT * 32 * 4;
constexpr size_t WS_R1 = WS_YG + (size_t)MT * 2048 * 2;
constexpr size_t WS_END = WS_R1 + (size_t)MT * NPROJ * 2;

constexpr size_t O_Y = 0;
constexpr size_t O_SSMP = (size_t)MT * 1024;
constexpr size_t O_CONVP = O_SSMP + (size_t)8 * 32 * 64 * 128;
constexpr size_t O_POOLP = O_CONVP + (size_t)8 * 3 * 4096;
constexpr size_t O_SSMS = O_POOLP + (size_t)8 * 15 * 1024;
constexpr size_t O_CONVS = O_SSMS + (size_t)128 * 32 * 64 * 128;
constexpr size_t O_POOLS = O_CONVS + (size_t)128 * 3 * 4096;

struct Args { const float* in[23]; float* out; unsigned char* ws; };
typedef const __attribute__((address_space(4))) Args* KArgs;
__device__ __forceinline__ KArgs kargs() { KArgs p = (KArgs)__builtin_amdgcn_kernarg_segment_ptr(); asm volatile("" : "+s"(p)); return p; }

__device__ __forceinline__ unsigned f2bf(float f) { unsigned u = __float_as_uint(f); u += 0x7FFFu + ((u >> 16) & 1u); return u >> 16; }
__device__ __forceinline__ unsigned pk2(float lo, float hi) { return f2bf(lo) | (f2bf(hi) << 16); }
__device__ __forceinline__ unsigned cvt_pk_bf16(float lo, float hi) { unsigned r; asm volatile("v_cvt_pk_bf16_f32 %0, %1, %2" : "=v"(r) : "v"(lo), "v"(hi)); return r; }
__device__ __forceinline__ float bflo(unsigned w) { return __uint_as_float(w << 16); }
__device__ __forceinline__ float bfhi(unsigned w) { return __uint_as_float(w & 0xffff0000u); }
__device__ __forceinline__ float bf1(bf16_t v) { return __uint_as_float(((unsigned)v) << 16); }
__device__ __forceinline__ float silu_f(float v) { return v / (1.0f + __expf(-v)); }
__device__ __forceinline__ float wave_sum(float v) {
#pragma unroll
    for (int o = 1; o < 64; o <<= 1) v += __shfl_xor(v, o);
    return v;
}
#define LDS_WAIT() asm volatile("s_waitcnt lgkmcnt(0)" ::: "memory")

constexpr int BM = 256, BK = 64, HALF = 128, HTB = HALF * BK * 2, NXCD = 8, WGM = 8;
__device__ __forceinline__ int lds_byte(int r, int c) { const int st = (r >> 4) * 2 + (c >> 5), rr = r & 15, cc = c & 31, ob = rr * 64 + cc * 2; return st * 1024 + (ob ^ (((ob >> 9) & 1) << 5)); }
__device__ __forceinline__ void stage_rc(int b, int& R, int& C) { const int st = b / 1024, sb = b % 1024, swz = sb ^ (((sb >> 9) & 1) << 5); R = (st >> 1) * 16 + swz / 64; C = (st & 1) * 32 + (swz % 64) / 2; }
__device__ __forceinline__ int perm32(int rho) { const int n = rho >> 4, i = rho & 15; return 8 * (i >> 2) + 4 * n + (i & 3); }

struct Unit { int pm, pn; };
struct Order {
    int nM, nN, nwg, G, c;
    __device__ __forceinline__ void init(int nM_, int nN_, int G_, int c_) { nM = nM_; nN = nN_; nwg = nM * nN; G = G_; c = c_; }
    __device__ __forceinline__ bool next(int i, Unit& u) const {
        const long L = (long)i * G + c; if (L >= nwg) return false;
        int wgid = (int)L; { const int q = nwg / NXCD, r = nwg % NXCD, xcd = wgid % NXCD, off = wgid / NXCD; wgid = (xcd < r ? xcd * (q + 1) : r * (q + 1) + (xcd - r) * q) + off; }
        const int nig = WGM * nN, gid = wgid / nig, fm = gid * WGM, gsz = (nM - fm) < WGM ? (nM - fm) : WGM;
        u.pm = fm + ((wgid % nig) % gsz); u.pn = (wgid % nig) / gsz; return true;
    }
};

template <class Epi>
__device__ __forceinline__ void gemm_phase(LAS unsigned char* lds, const bf16_t* A, int lda, int a_pn_off, const bf16_t* Bt, int K, const Order& S, const Epi& E) {
    int tid_ = threadIdx.x; asm volatile("" : "+v"(tid_));
    const int tid = tid_, wid = __builtin_amdgcn_readfirstlane(tid >> 6), lane = tid & 63, wr = wid >> 2, wc = wid & 3, fr = lane & 15, fq = lane >> 4;
    const int nt = K / BK;
    unsigned voffA[2], voffB[2];
#pragma unroll
    for (int i = 0; i < 2; ++i) { int R, C; stage_rc(tid * 16 + i * 8192, R, C); const int Rb = Epi::PERM ? ((R & ~31) + perm32(R & 31)) : R;
        voffA[i] = (unsigned)(R * lda + C) * 2u; voffB[i] = (unsigned)(Rb * K + C) * 2u; }
    const size_t kstep = (size_t)(BK * 2);
    const size_t hstepA = (size_t)HALF * lda * 2, hstepB = (size_t)HALF * K * 2;
    const size_t tstepA = 2 * hstepA, tstepB = 2 * hstepB;
    const unsigned ldsw = (unsigned)wid * 1024u;
    const int aoff = lds_byte(wr * 64 + fr, fq * 8), boff = lds_byte(wc * 32 + fr, fq * 8);
#define PG8_SA(b, h) (((b) * 2 + (h)) * HTB)
#define PG8_SB(b, h) ((4 + (b) * 2 + (h)) * HTB)
#define PG8_STAGE(bufoff, gbase, voff) do { _Pragma("unroll") for (int _i = 0; _i < 2; ++_i) \
        __builtin_amdgcn_global_load_lds((const unsigned*)((const char*)(gbase) + (voff)[_i]), (LAS unsigned*)(lds + (bufoff) + ldsw + _i * 8192), 16, 0, 0); } while (0)
#define PG8_LDA(dst, b, h) do { _Pragma("unroll") for (int m = 0; m < 4; ++m) _Pragma("unroll") for (int k = 0; k < 2; ++k) dst[m][k] = *(const LAS bf16x8*)(lds + PG8_SA(b, h) + aoff + m * 2048 + k * 1024); } while (0)
#define PG8_LDB(dst, b, h) do { _Pragma("unroll") for (int n = 0; n < 2; ++n) _Pragma("unroll") for (int k = 0; k < 2; ++k) dst[n][k] = *(const LAS bf16x8*)(lds + PG8_SB(b, h) + boff + n * 2048 + k * 1024); } while (0)
#define PG8_MMA(ai, bj, At, Bt_) do { __builtin_amdgcn_s_setprio(1); _Pragma("unroll") for (int m = 0; m < 4; ++m) _Pragma("unroll") for (int n = 0; n < 2; ++n) _Pragma("unroll") for (int k = 0; k < 2; ++k) \
        acc[ai][bj][m][n] = __builtin_amdgcn_mfma_f32_16x16x32_bf16(Bt_[n][k], At[m][k], acc[ai][bj][m][n], 0, 0, 0); __builtin_amdgcn_s_setprio(0); } while (0)
#define PG8_WAIT_V(n) asm volatile("s_waitcnt vmcnt(" #n ")" ::: "memory")
#define PG8_WAIT_L(n) asm volatile("s_waitcnt lgkmcnt(" #n ")" ::: "memory")
#define PG8_BAR __builtin_amdgcn_s_barrier()
#define PG8_SCHED __builtin_amdgcn_sched_barrier(0)
    Unit cur, nxt; int ui = 0;
    if (!S.next(0, cur)) return;
    f32x4 acc[2][2][4][2];
#pragma unroll
    for (int a = 0; a < 2; ++a)
#pragma unroll
        for (int b = 0; b < 2; ++b)
#pragma unroll
            for (int m = 0; m < 4; ++m)
#pragma unroll
                for (int n = 0; n < 2; ++n) acc[a][b][m][n] = (f32x4){0.f, 0.f, 0.f, 0.f};
    bf16x8 At[4][2], B0[2][2], B1[2][2];
    const char* cA = (const char*)A + (size_t)cur.pm * tstepA + (size_t)cur.pn * a_pn_off * 2; const char* cB = (const char*)Bt + (size_t)cur.pn * tstepB;
    PG8_STAGE(PG8_SB(0, 0), cB, voffB); PG8_STAGE(PG8_SA(0, 0), cA, voffA); PG8_STAGE(PG8_SB(0, 1), cB + hstepB, voffB); PG8_STAGE(PG8_SA(0, 1), cA + hstepA, voffA);
    if (wr == 1) PG8_BAR;
    PG8_WAIT_V(4); PG8_BAR;
    PG8_STAGE(PG8_SB(1, 0), cB + kstep, voffB); PG8_STAGE(PG8_SA(1, 0), cA + kstep, voffA); PG8_STAGE(PG8_SB(1, 1), cB + hstepB + kstep, voffB);
    PG8_WAIT_V(6); PG8_BAR;
    for (;;) {
        const bool has_next = S.next(ui + 1, nxt);
        const char* nA = has_next ? (const char*)A + (size_t)nxt.pm * tstepA + (size_t)nxt.pn * a_pn_off * 2 : cA; const char* nB = has_next ? (const char*)Bt + (size_t)nxt.pn * tstepB : cB;
        for (int t = 0; t < nt; t += 2) {
            const bool last = (t == nt - 2);
            const char* a1 = cA + (size_t)(t + 1) * kstep;
            const char* a2 = last ? nA : cA + (size_t)(t + 2) * kstep; const char* b2 = last ? nB : cB + (size_t)(t + 2) * kstep;
            const char* a3 = a2 + kstep; const char* b3 = b2 + kstep;
            PG8_LDB(B0, 0, 0); PG8_SCHED; PG8_LDA(At, 0, 0); PG8_STAGE(PG8_SA(1, 1), a1 + hstepA, voffA);
            PG8_WAIT_L(8); PG8_BAR; PG8_WAIT_L(0); PG8_MMA(0, 0, At, B0); PG8_BAR; PG8_SCHED;
            PG8_LDB(B1, 0, 1); PG8_STAGE(PG8_SB(0, 0), b2, voffB);
            PG8_BAR; PG8_WAIT_L(0); PG8_MMA(0, 1, At, B1); PG8_BAR;
            PG8_LDA(At, 0, 1); PG8_STAGE(PG8_SA(0, 0), a2, voffA);
            PG8_BAR; PG8_WAIT_L(0); PG8_MMA(1, 0, At, B0); PG8_BAR; PG8_SCHED;
            PG8_STAGE(PG8_SB(0, 1), b2 + hstepB, voffB);
            PG8_WAIT_V(6); PG8_BAR; PG8_MMA(1, 1, At, B1); PG8_BAR;
            PG8_LDB(B0, 1, 0); PG8_SCHED; PG8_LDA(At, 1, 0); PG8_STAGE(PG8_SA(0, 1), a2 + hstepA, voffA);
            PG8_WAIT_L(8); PG8_BAR; PG8_WAIT_L(0); PG8_MMA(0, 0, At, B0); PG8_BAR; PG8_SCHED;
            PG8_LDB(B1, 1, 1); PG8_STAGE(PG8_SB(1, 0), b3, voffB);
            PG8_BAR; PG8_WAIT_L(0); PG8_MMA(0, 1, At, B1); PG8_BAR;
            PG8_LDA(At, 1, 1); PG8_STAGE(PG8_SA(1, 0), a3, voffA);
            PG8_BAR; PG8_WAIT_L(0); PG8_MMA(1, 0, At, B0); PG8_BAR; PG8_SCHED;
            PG8_STAGE(PG8_SB(1, 1), b3 + hstepB, voffB);
            PG8_WAIT_V(6); PG8_BAR; PG8_MMA(1, 1, At, B1); PG8_BAR;
        }
        E(acc, cur, wr, wc, fr, fq);
        if (!has_next) break;
#pragma unroll
        for (int a = 0; a < 2; ++a)
#pragma unroll
            for (int b = 0; b < 2; ++b)
#pragma unroll
                for (int m = 0; m < 4; ++m)
#pragma unroll
                    for (int n = 0; n < 2; ++n) acc[a][b][m][n] = (f32x4){0.f, 0.f, 0.f, 0.f};
        cur = nxt; cA = nA; cB = nB; ++ui;
    }
    PG8_WAIT_V(0);
    if (wr == 0) PG8_BAR;
    PG8_BAR;
#undef PG8_SA
#undef PG8_SB
#undef PG8_STAGE
#undef PG8_LDA
#undef PG8_LDB
#undef PG8_MMA
#undef PG8_WAIT_V
#undef PG8_WAIT_L
#undef PG8_BAR
#undef PG8_SCHED
}

__device__ __forceinline__ float row_rstd(const float* ssq, int r, int fq) {
    const f32x4 q = *(const f32x4*)(ssq + (size_t)r * 16 + fq * 4);
    float s = (q[0] + q[1]) + (q[2] + q[3]);
    s += __shfl_xor(s, 16); s += __shfl_xor(s, 32);
    return rsqrtf(s * (1.0f / 1024.0f) + EPS);
}

struct EpiSwiGLU {
    static constexpr bool PERM = true;
    bf16_t* act; const float* ssq;
    __device__ __forceinline__ void operator()(const f32x4 (&acc)[2][2][4][2], const Unit& u, int wr, int wc, int fr, int fq) const {
        const int row0 = u.pm * BM + wr * 64 + fr, col0 = u.pn * 128 + wc * 32 + 8 * fq;
#pragma unroll
        for (int ai = 0; ai < 2; ++ai)
#pragma unroll
            for (int m = 0; m < 4; ++m) {
                const int r = row0 + ai * HALF + m * 16;
                const float rs = row_rstd(ssq, r, fq);
                float o[8];
#pragma unroll
                for (int n = 0; n < 2; ++n)
#pragma unroll
                    for (int j = 0; j < 4; ++j) { const float g = acc[ai][0][m][n][j] * rs, uu = acc[ai][1][m][n][j] * rs; o[n * 4 + j] = silu_f(g) * uu; }
                u32x4 w; w.x = cvt_pk_bf16(o[0], o[1]); w.y = cvt_pk_bf16(o[2], o[3]); w.z = cvt_pk_bf16(o[4], o[5]); w.w = cvt_pk_bf16(o[6], o[7]);
                *(u32x4*)(act + (size_t)r * FF + col0) = w;
            }
    }
};

struct EpiResid {
    static constexpr bool PERM = false;
    const float* rin0; const float* rin1; float* rout; bf16_t* xb; float* ssq; float scale;
    __device__ __forceinline__ void operator()(const f32x4 (&acc)[2][2][4][2], const Unit& u, int wr, int wc, int fr, int fq) const {
        const float* rin = (u.pm < 64) ? rin0 : rin1;
        const int row0 = u.pm * BM + wr * 64 + fr, col0 = u.pn * BM + wc * 32 + 4 * fq;
#pragma unroll
        for (int ai = 0; ai < 2; ++ai)
#pragma unroll
            for (int m = 0; m < 4; ++m) {
                const int r = row0 + ai * HALF + m * 16; const size_t off = (size_t)r * DM + col0; float ss = 0.f;
#pragma unroll
                for (int bj = 0; bj < 2; ++bj)
#pragma unroll
                    for (int n = 0; n < 2; ++n) {
                        const size_t c = off + bj * HALF + n * 16;
                        const f32x4 b = *(const f32x4*)(rin + c);
                        const f32x4 o = b + acc[ai][bj][m][n] * scale;
                        *(f32x4*)(rout + c) = o;
                        u32x2 w; w.x = cvt_pk_bf16(o[0], o[1]); w.y = cvt_pk_bf16(o[2], o[3]);
                        *(u32x2*)(xb + c) = w;
                        ss += (o[0] * o[0] + o[1] * o[1]) + (o[2] * o[2] + o[3] * o[3]);
                    }
                ss += __shfl_xor(ss, 16); ss += __shfl_xor(ss, 32);
                if (fq == 0) ssq[(size_t)r * 16 + u.pn * 4 + wc] = ss;
            }
    }
};

struct EpiProj {
    static constexpr bool PERM = true;
    bf16_t* proj; float* dtraw; const float* ssq; float* convp; float* convs;
    __device__ __forceinline__ void operator()(const f32x4 (&acc)[2][2][4][2], const Unit& u, int wr, int wc, int fr, int fq) const {
        const int row0 = u.pm * BM + wr * 64 + fr, cb = u.pn * BM + wc * 32 + 8 * fq;
#pragma unroll
        for (int ai = 0; ai < 2; ++ai)
#pragma unroll
            for (int m = 0; m < 4; ++m) {
                const int r = row0 + ai * HALF + m * 16;
                const float rs = row_rstd(ssq, r, fq);
                float* cdst = nullptr;
                if (r < MP) { const int t = r & 2047; if (t >= 2045) cdst = convp + ((size_t)(r >> 11) * 3 + (t - 2045)) * 4096; }
                else { const int q = r - MP, t = q & 7; if (t >= 5) cdst = convs + ((size_t)(q >> 3) * 3 + (t - 5)) * 4096; }
#pragma unroll
                for (int bj = 0; bj < 2; ++bj) {
                    const int c0 = cb + bj * HALF;
                    const f32x4 v0 = acc[ai][bj][m][0] * rs, v1 = acc[ai][bj][m][1] * rs;
                    if (c0 < NPROJ) {
                        u32x4 w; w.x = cvt_pk_bf16(v0[0], v0[1]); w.y = cvt_pk_bf16(v0[2], v0[3]); w.z = cvt_pk_bf16(v1[0], v1[1]); w.w = cvt_pk_bf16(v1[2], v1[3]);
                        *(u32x4*)(proj + (size_t)r * NPROJ + c0) = w;
                        if (c0 >= 2048 && cdst) { *(f32x4*)(cdst + (c0 - 2048)) = v0; *(f32x4*)(cdst + (c0 - 2048) + 4) = v1; }
                    } else if (c0 < NIN) {
                        float* d = dtraw + (size_t)r * 32 + (c0 - NPROJ);
                        *(f32x4*)d = v0; *(f32x4*)(d + 4) = v1;
                    }
                }
            }
    }
};

struct EpiPoolIn {
    static constexpr bool PERM = true;
    bf16_t* ub; const float* ssq; float* poolp; float* pools;
    __device__ __forceinline__ void operator()(const f32x4 (&acc)[2][2][4][2], const Unit& u, int wr, int wc, int fr, int fq) const {
        const int row0 = u.pm * BM + wr * 64 + fr, cb = u.pn * BM + wc * 32 + 8 * fq;
#pragma unroll
        for (int ai = 0; ai < 2; ++ai)
#pragma unroll
            for (int m = 0; m < 4; ++m) {
                const int r = row0 + ai * HALF + m * 16;
                const float rs = row_rstd(ssq, r, fq);
                float* pdst = nullptr;
                if (r < MP) { const int t = r & 2047; if (t >= 2033) pdst = poolp + ((size_t)(r >> 11) * 15 + (t - 2033)) * 1024; }
                else { const int q = r - MP, t = q & 7; pdst = pools + ((size_t)(q >> 3) * 15 + 7 + t) * 1024; }
#pragma unroll
                for (int bj = 0; bj < 2; ++bj) {
                    const int c0 = cb + bj * HALF;
                    const f32x4 v0 = acc[ai][bj][m][0] * rs, v1 = acc[ai][bj][m][1] * rs;
                    u32x4 w; w.x = cvt_pk_bf16(v0[0], v0[1]); w.y = cvt_pk_bf16(v0[2], v0[3]); w.z = cvt_pk_bf16(v1[0], v1[1]); w.w = cvt_pk_bf16(v1[2], v1[3]);
                    *(u32x4*)(ub + (size_t)r * DM + c0) = w;
                    if (pdst) { *(f32x4*)(pdst + c0) = v0; *(f32x4*)(pdst + c0 + 4) = v1; }
                }
            }
    }
};

struct EpiBf16 {
    static constexpr bool PERM = true;
    bf16_t* O; int ldc;
    __device__ __forceinline__ void operator()(const f32x4 (&acc)[2][2][4][2], const Unit& u, int wr, int wc, int fr, int fq) const {
        const int row0 = u.pm * BM + wr * 64 + fr, cb = u.pn * BM + wc * 32 + 8 * fq;
#pragma unroll
        for (int ai = 0; ai < 2; ++ai)
#pragma unroll
            for (int m = 0; m < 4; ++m) {
                const int r = row0 + ai * HALF + m * 16;
#pragma unroll
                for (int bj = 0; bj < 2; ++bj) {
                    const f32x4 v0 = acc[ai][bj][m][0], v1 = acc[ai][bj][m][1];
                    u32x4 w; w.x = cvt_pk_bf16(v0[0], v0[1]); w.y = cvt_pk_bf16(v0[2], v0[3]); w.z = cvt_pk_bf16(v1[0], v1[1]); w.w = cvt_pk_bf16(v1[2], v1[3]);
                    *(u32x4*)(O + (size_t)r * ldc + cb + bj * HALF) = w;
                }
            }
    }
};

__device__ __forceinline__ void transpose_item(const float* W, int ldw, const float* kscale, bf16_t* WT, int K, int k0, int n0, int drow0, LAS float* scr, int lane) {
#pragma unroll 8
    for (int i = 0; i < 32; ++i) { const int kk = 2 * i + (lane >> 5); float v = W[(size_t)(k0 + kk) * ldw + n0 + (lane & 31)]; if (kscale) v *= kscale[k0 + kk]; scr[kk * 33 + (lane & 31)] = v; }
    LDS_WAIT(); asm volatile("" ::: "memory");
    const int c = lane & 7;
#pragma unroll
    for (int j = 0; j < 4; ++j) { const int n = (lane >> 3) + 8 * j; const LAS float* s = scr + (8 * c) * 33 + n;
        u32x4 o; o.x = pk2(s[0 * 33], s[1 * 33]); o.y = pk2(s[2 * 33], s[3 * 33]); o.z = pk2(s[4 * 33], s[5 * 33]); o.w = pk2(s[6 * 33], s[7 * 33]);
        *(u32x4*)(WT + (size_t)(drow0 + n) * K + k0 + 8 * c) = o; }
    LDS_WAIT(); asm volatile("" ::: "memory");
}

__device__ __forceinline__ void phase_prep(LAS unsigned char* lds, int G, int bid) {
    const KArgs ap = kargs();
#define a (*ap)
    int tid_ = threadIdx.x; asm volatile("" : "+v"(tid_));
    const int tid = tid_, lane = tid & 63, wave = tid >> 6;
    LAS float* scr = (LAS float*)(lds + wave * 8448);
    const int gw = bid * 8 + wave, NGW = G * 8;
    unsigned char* ws = a.ws;
    constexpr int I_FF = 1408, N_FF = 12 * I_FF, I_IN = 16 * 193, I_OUT = 32 * 32, I_PIN = 512, I_PG = 128, I_POUT = 512;
    constexpr int NITEMS = N_FF + I_IN + I_OUT + I_PIN + I_PG + I_POUT;
    for (int it = gw; it < NITEMS; it += NGW) {
        int r = it;
        if (r < N_FF) {
            const int mat = r / I_FF, rr = r % I_FF, type = mat >> 2, f = mat & 3;
            if (type < 2) {
                const int kb = rr / 88, nb = rr % 88, n0 = nb * 32;
                const float* W = (type == 0 ? a.in[6] : a.in[7]) + (size_t)f * 1024 * 2816;
                transpose_item(W, 2816, a.in[5] + f * 1024, (bf16_t*)(ws + WS_WGU) + (size_t)f * 5632 * 1024, 1024, kb * 64, n0, (n0 >> 7) * 256 + (n0 & 127) + type * 128, scr, lane);
            } else {
                const int kb = rr / 32, nb = rr % 32;
                transpose_item(a.in[8] + (size_t)f * 2816 * 1024, 1024, nullptr, (bf16_t*)(ws + WS_WD) + (size_t)f * 1024 * 2816, 2816, kb * 64, nb * 32, nb * 32, scr, lane);
            }
            continue;
        }
        r -= N_FF;
        if (r < I_IN) { const int kb = r / 193, nb = r % 193; transpose_item(a.in[10], NIN, a.in[9], (bf16_t*)(ws + WS_WIN), 1024, kb * 64, nb * 32, nb * 32, scr, lane); continue; }
        r -= I_IN;
        if (r < I_OUT) { const int kb = r / 32, nb = r % 32; transpose_item(a.in[17], 1024, a.in[16], (bf16_t*)(ws + WS_WOUT), 2048, kb * 64, nb * 32, nb * 32, scr, lane); continue; }
        r -= I_OUT;
        if (r < I_PIN) { const int kb = r / 32, nb = r % 32; transpose_item(a.in[18], 1024, a.in[9] + 1024, (bf16_t*)(ws + WS_WPIN), 1024, kb * 64, nb * 32, nb * 32, scr, lane); continue; }
        r -= I_PIN;
        if (r < I_PG) { const int g = r >> 5, rr = r & 31, kb = rr >> 3, nb = rr & 7; transpose_item(a.in[19] + (size_t)g * 65536, 256, nullptr, (bf16_t*)(ws + WS_WPG), 256, kb * 64, nb * 32, g * 256 + nb * 32, scr, lane); continue; }
        r -= I_PG;
        { const int kb = r / 32, nb = r % 32; transpose_item(a.in[21], 1024, a.in[20], (bf16_t*)(ws + WS_WPOUT), 1024, kb * 64, nb * 32, nb * 32, scr, lane); }
    }
    {
        u32x4* z = (u32x4*)((bf16_t*)(ws + WS_WIN) + (size_t)NIN * 1024);
        const int nz = (NINP - NIN) * 1024 / 8;
        for (int i = bid * NTHR + tid; i < nz; i += G * NTHR) z[i] = (u32x4){0u, 0u, 0u, 0u};
    }
    bf16_t* xb = (bf16_t*)(ws + WS_XB); float* ssq = (float*)(ws + WS_SSQ);
    for (int row = gw; row < MT; row += NGW) {
        const float* xr = (row < MP) ? a.in[0] + (size_t)row * DM : a.in[1] + (size_t)(row - MP) * DM;
        float s = 0.f;
#pragma unroll
        for (int j = 0; j < 4; ++j) {
            const f32x4 v = *(const f32x4*)(xr + 4 * lane + 256 * j);
            s += (v[0] * v[0] + v[1] * v[1]) + (v[2] * v[2] + v[3] * v[3]);
            u32x2 w; w.x = cvt_pk_bf16(v[0], v[1]); w.y = cvt_pk_bf16(v[2], v[3]);
            *(u32x2*)(xb + (size_t)row * DM + 4 * lane + 256 * j) = w;
        }
        s = wave_sum(s);
        if (lane < 16) ssq[(size_t)row * 16 + lane] = (lane == 0) ? s : 0.f;
    }
#undef a
}

constexpr int SX = 72, SW = 136;
constexpr int L_XT = 0;
constexpr int L_BS = L_XT + 64 * SX * 2;
constexpr int L_CS = L_BS + 64 * SW * 2;
constexpr int L_BWT = L_CS + 64 * SW * 2;
constexpr int L_LS = L_BWT + 128 * SX * 2;
constexpr int L_HB = L_LS + 64 * SX * 2;
constexpr int L_ZS = L_HB + 64 * SW * 2;
constexpr int L_DT = L_ZS + 64 * SX * 2;
constexpr int L_AC = L_DT + 256;
constexpr int L_SCAN_END = L_AC + 256;
static_assert(L_SCAN_END <= LDS_BYTES, "scan LDS");

__device__ __forceinline__ f32x4 mfma16(bf16x8 a, bf16x8 b, f32x4 c) { return __builtin_amdgcn_mfma_f32_16x16x32_bf16(a, b, c, 0, 0, 0); }

__device__ __forceinline__ void unpack8(const u32x4 w, float (&o)[8]) {
    o[0] = bflo(w.x); o[1] = bfhi(w.x); o[2] = bflo(w.y); o[3] = bfhi(w.y); o[4] = bflo(w.z); o[5] = bfhi(w.z); o[6] = bflo(w.w); o[7] = bfhi(w.w);
}

__device__ __forceinline__ void scan_prompt_item(LAS unsigned char* lds, int b, int h) {
    const KArgs ap = kargs();
#define a (*ap)
    int tid_ = threadIdx.x; asm volatile("" : "+v"(tid_));
    const int tid = tid_, lane = tid & 63, w = __builtin_amdgcn_readfirstlane(tid >> 6), fr = lane & 15, fq = lane >> 4;
    const int g = h >> 2;
    unsigned char* ws = a.ws;
    const bf16_t* proj = (const bf16_t*)(ws + WS_R1);
    const float* dtraw = (const float*)(ws + WS_DT);
    bf16_t* yg = (bf16_t*)(ws + WS_YG); float* yss = (float*)(ws + WS_YSS);
    const int r0 = b * 2048;
    const float dtb = a.in[13][h], Ah = -__expf(a.in[14][h]), Dh = a.in[15][h];
    LAS bf16_t* XT = (LAS bf16_t*)(lds + L_XT); LAS bf16_t* BS = (LAS bf16_t*)(lds + L_BS); LAS bf16_t* CS = (LAS bf16_t*)(lds + L_CS);
    LAS bf16_t* BWT = (LAS bf16_t*)(lds + L_BWT); LAS bf16_t* LS = (LAS bf16_t*)(lds + L_LS); LAS bf16_t* HB = (LAS bf16_t*)(lds + L_HB);
    LAS bf16_t* ZS = (LAS bf16_t*)(lds + L_ZS); LAS float* DTS = (LAS float*)(lds + L_DT); LAS float* ACS = (LAS float*)(lds + L_AC);
    const int cgi = tid % 40, seg = tid / 40, s0 = seg * 6;
    const bool conv_on = (s0 < 64);
    const int colbase = (cgi < 8) ? (2048 + h * 64 + cgi * 8) : (cgi < 24) ? (4096 + g * 128 + (cgi - 8) * 8) : (5120 + g * 128 + (cgi - 24) * 8);
    float cw[4][8], cbias[8];
    {
        const float* cwp = a.in[11] + (colbase - 2048); const float* cbp = a.in[12] + (colbase - 2048);
#pragma unroll
        for (int k = 0; k < 4; ++k)
#pragma unroll
            for (int e = 0; e < 8; ++e) cw[k][e] = cwp[k * 4096 + e];
#pragma unroll
        for (int e = 0; e < 8; ++e) cbias[e] = cbp[e];
    }
    for (int i = tid; i < 64 * SW / 2; i += NTHR) ((LAS unsigned*)HB)[i] = 0u;
    f32x4 hacc[4];
#pragma unroll
    for (int q = 0; q < 4; ++q) hacc[q] = (f32x4){0.f, 0.f, 0.f, 0.f};

#pragma unroll 1
    for (int c = 0; c < 32; ++c) {
        const int t0 = c * 64;
        float dtl, acl, wgt;
        {
            const float v = dtraw[(size_t)(r0 + t0 + lane) * 32 + h] + dtb;
            dtl = (v > 20.f) ? v : log1pf(__expf(v));
            float s = dtl * Ah;
#pragma unroll
            for (int o = 1; o < 64; o <<= 1) { const float n = __shfl_up(s, o); if (lane >= o) s += n; }
            acl = s;
            const float tot = __shfl(s, 63);
            wgt = dtl * __expf(tot - acl);
            if (w == 0) { DTS[lane] = dtl; ACS[lane] = acl; }
        }
        {
            const int s = tid >> 3, q = tid & 7;
            const u32x4 zv = *(const u32x4*)(proj + (size_t)(r0 + t0 + s) * NPROJ + h * 64 + q * 8);
            *(LAS u32x4*)(ZS + s * SX + q * 8) = zv;
        }
        float wsh[6];
#pragma unroll
        for (int e = 0; e < 6; ++e) { const int si = s0 + e; wsh[e] = __shfl(wgt, si < 64 ? si : 63); }
        if (conv_on) {
            u32x4 rows[9];
#pragma unroll
            for (int i = 0; i < 9; ++i) {
                const int t = t0 + s0 - 3 + i;
                const int tc = t < 0 ? 0 : (t > 2047 ? 2047 : t);
                u32x4 v = *(const u32x4*)(proj + (size_t)(r0 + tc) * NPROJ + colbase);
                if (t < 0) v = (u32x4){0u, 0u, 0u, 0u};
                rows[i] = v;
            }
            float p0[8], p1[8], p2[8];
            unpack8(rows[0], p0); unpack8(rows[1], p1); unpack8(rows[2], p2);
#pragma unroll
            for (int e = 0; e < 6; ++e) {
                const int s = s0 + e;
                float cur[8]; unpack8(rows[3 + e], cur);
                if (s < 64) {
                    float y[8];
#pragma unroll
                    for (int k = 0; k < 8; ++k) { const float v = cbias[k] + cw[0][k] * p0[k] + cw[1][k] * p1[k] + cw[2][k] * p2[k] + cw[3][k] * cur[k]; y[k] = silu_f(v); }
                    if (cgi < 8) {
#pragma unroll
                        for (int k = 0; k < 8; ++k) XT[(cgi * 8 + k) * SX + s] = (bf16_t)f2bf(y[k]);
                    } else if (cgi < 24) {
                        const int n0 = (cgi - 8) * 8;
                        u32x4 pk; pk.x = pk2(y[0], y[1]); pk.y = pk2(y[2], y[3]); pk.z = pk2(y[4], y[5]); pk.w = pk2(y[6], y[7]);
                        *(LAS u32x4*)(BS + s * SW + n0) = pk;
                        const float ws_ = wsh[e];
#pragma unroll
                        for (int k = 0; k < 8; ++k) BWT[(n0 + k) * SX + s] = (bf16_t)f2bf(y[k] * ws_);
                    } else {
                        const int n0 = (cgi - 24) * 8;
                        u32x4 pk; pk.x = pk2(y[0], y[1]); pk.y = pk2(y[2], y[3]); pk.z = pk2(y[4], y[5]); pk.w = pk2(y[6], y[7]);
                        *(LAS u32x4*)(CS + s * SW + n0) = pk;
                    }
                }
#pragma unroll
                for (int k = 0; k < 8; ++k) { p0[k] = p1[k]; p1[k] = p2[k]; p2[k] = cur[k]; }
            }
        }
        __syncthreads();
        {
            const int lt = w >> 1;
#pragma unroll
            for (int q = 0; q < 2; ++q) {
                const int st = (w & 1) * 2 + q;
                f32x4 acc = (f32x4){0.f, 0.f, 0.f, 0.f};
                if (st <= lt) {
#pragma unroll
                    for (int kk = 0; kk < 4; ++kk) {
                        const bf16x8 av = *(const LAS bf16x8*)(CS + (lt * 16 + fr) * SW + kk * 32 + fq * 8);
                        const bf16x8 bv = *(const LAS bf16x8*)(BS + (st * 16 + fr) * SW + kk * 32 + fq * 8);
                        acc = mfma16(av, bv, acc);
                    }
                }
                const int s = st * 16 + fr; const float acs = ACS[s], dts = DTS[s];
#pragma unroll
                for (int j = 0; j < 4; ++j) {
                    const int l = lt * 16 + fq * 4 + j;
                    const float v = (s <= l) ? acc[j] * __expf(ACS[l] - acs) * dts : 0.f;
                    LS[l * SX + s] = (bf16_t)f2bf(v);
                }
            }
        }
        __syncthreads();
        {
            const int lt = w >> 1; float ssr[4] = {0.f, 0.f, 0.f, 0.f};
#pragma unroll
            for (int q = 0; q < 2; ++q) {
                const int pt = (w & 1) * 2 + q;
                f32x4 a1 = (f32x4){0.f, 0.f, 0.f, 0.f}, a2 = (f32x4){0.f, 0.f, 0.f, 0.f};
#pragma unroll
                for (int kk = 0; kk < 2; ++kk) {
                    const bf16x8 av = *(const LAS bf16x8*)(LS + (lt * 16 + fr) * SX + kk * 32 + fq * 8);
                    const bf16x8 bv = *(const LAS bf16x8*)(XT + (pt * 16 + fr) * SX + kk * 32 + fq * 8);
                    a1 = mfma16(av, bv, a1);
                }
#pragma unroll
                for (int kk = 0; kk < 4; ++kk) {
                    const bf16x8 av = *(const LAS bf16x8*)(CS + (lt * 16 + fr) * SW + kk * 32 + fq * 8);
                    const bf16x8 bv = *(const LAS bf16x8*)(HB + (pt * 16 + fr) * SW + kk * 32 + fq * 8);
                    a2 = mfma16(av, bv, a2);
                }
                const int p = pt * 16 + fr, l0 = lt * 16 + fq * 4;
                const u32x2 xw = *(const LAS u32x2*)(XT + p * SX + l0);
                const float xv[4] = {bflo(xw.x), bfhi(xw.x), bflo(xw.y), bfhi(xw.y)};
#pragma unroll
                for (int j = 0; j < 4; ++j) {
                    const int l = l0 + j;
                    const float y = a1[j] + __expf(ACS[l]) * a2[j] + Dh * xv[j];
                    const float z = bf1(ZS[l * SX + p]);
                    const float yv = y * silu_f(z);
                    yg[(size_t)(r0 + t0 + l) * DI + h * 64 + p] = (bf16_t)f2bf(yv);
                    ssr[j] += yv * yv;
                }
            }
#pragma unroll
            for (int j = 0; j < 4; ++j) {
                float s = ssr[j];
                s += __shfl_xor(s, 1); s += __shfl_xor(s, 2); s += __shfl_xor(s, 4); s += __shfl_xor(s, 8);
                if (fr == 0) yss[(size_t)(r0 + t0 + lt * 16 + fq * 4 + j) * 64 + h * 2 + (w & 1)] = s;
            }
        }
        {
            const int pt = w >> 1; const float dec = __expf(ACS[63]);
#pragma unroll
            for (int q = 0; q < 4; ++q) {
                const int nt = (w & 1) * 4 + q;
                hacc[q] = hacc[q] * dec;
#pragma unroll
                for (int kk = 0; kk < 2; ++kk) {
                    const bf16x8 av = *(const LAS bf16x8*)(XT + (pt * 16 + fr) * SX + kk * 32 + fq * 8);
                    const bf16x8 bv = *(const LAS bf16x8*)(BWT + (nt * 16 + fr) * SX + kk * 32 + fq * 8);
                    hacc[q] = mfma16(av, bv, hacc[q]);
                }
            }
        }
        __syncthreads();
        {
            const int pt = w >> 1;
#pragma unroll
            for (int q = 0; q < 4; ++q) {
                const int n = ((w & 1) * 4 + q) * 16 + fr;
#pragma unroll
                for (int j = 0; j < 4; ++j) HB[(pt * 16 + fq * 4 + j) * SW + n] = (bf16_t)f2bf(hacc[q][j]);
            }
        }
    }
    {
        float* so = a.out + O_SSMP + (size_t)(b * 32 + h) * 64 * 128;
        const int pt = w >> 1;
#pragma unroll
        for (int q = 0; q < 4; ++q) {
            const int n = ((w & 1) * 4 + q) * 16 + fr;
#pragma unroll
            for (int j = 0; j < 4; ++j) so[(size_t)(pt * 16 + fq * 4 + j) * 128 + n] = hacc[q][j];
        }
    }
#undef a
}

constexpr int LS_X = 0, LS_B = LS_X + 8 * 64 * 4, LS_C = LS_B + 8 * 128 * 4, LS_DT = LS_C + 8 * 128 * 4, LS_Y = LS_DT + 64, LS_END = LS_Y + 8 * 64 * 4;
__device__ __forceinline__ void scan_sample_item(LAS unsigned char* lds, int b, int h) {
    const KArgs ap = kargs();
#define a (*ap)
    int tid_ = threadIdx.x; asm volatile("" : "+v"(tid_));
    const int tid = tid_, lane = tid & 63, w = tid >> 6;
    const int g = h >> 2;
    unsigned char* ws = a.ws;
    const bf16_t* proj = (const bf16_t*)(ws + WS_R1);
    const float* dtraw = (const float*)(ws + WS_DT);
    bf16_t* yg = (bf16_t*)(ws + WS_YG); float* yss = (float*)(ws + WS_YSS);
    const int r0 = MP + b * 8;
    const float Ah = -__expf(a.in[14][h]), Dh = a.in[15][h];
    LAS float* XS = (LAS float*)(lds + LS_X); LAS float* BSs = (LAS float*)(lds + LS_B); LAS float* CSs = (LAS float*)(lds + LS_C);
    LAS float* DTs = (LAS float*)(lds + LS_DT); LAS float* YS = (LAS float*)(lds + LS_Y);
    const int p = tid >> 3, nb = (tid & 7) * 16;
    const float* hin = a.in[2] + ((size_t)(b * 32 + h) * 64 + p) * 128 + nb;
    f32x4 hs[4];
#pragma unroll
    for (int i = 0; i < 4; ++i) hs[i] = *(const f32x4*)(hin + 4 * i);
    if (tid < 320) {
        const int col = (tid < 64) ? (2048 + h * 64 + tid) : (tid < 192) ? (4096 + g * 128 + (tid - 64)) : (5120 + g * 128 + (tid - 192));
        const int ch = col - 2048;
        const float w0 = a.in[11][ch], w1 = a.in[11][4096 + ch], w2 = a.in[11][8192 + ch], w3 = a.in[11][12288 + ch], bb = a.in[12][ch];
        const float* cs = a.in[3] + (size_t)b * 3 * 4096 + ch;
        float q0 = cs[0], q1 = cs[4096], q2 = cs[8192];
        LAS float* dst = (tid < 64) ? (XS + tid) : (tid < 192) ? (BSs + (tid - 64)) : (CSs + (tid - 192));
        const int dstride = (tid < 64) ? 64 : 128;
#pragma unroll
        for (int t = 0; t < 8; ++t) {
            const float cur = bf1(proj[(size_t)(r0 + t) * NPROJ + col]);
            const float v = bb + w0 * q0 + w1 * q1 + w2 * q2 + w3 * cur;
            dst[t * dstride] = silu_f(v);
            q0 = q1; q1 = q2; q2 = cur;
        }
    } else if (tid < 328) {
        const int t = tid - 320;
        const float v = dtraw[(size_t)(r0 + t) * 32 + h] + a.in[13][h];
        DTs[t] = (v > 20.f) ? v : log1pf(__expf(v));
    }
    __syncthreads();
#pragma unroll
    for (int t = 0; t < 8; ++t) {
        const float dt = DTs[t], dec = __expf(dt * Ah), xv = XS[t * 64 + p] * dt;
        float yp = 0.f;
#pragma unroll
        for (int i = 0; i < 4; ++i) {
            const f32x4 bv = *(const LAS f32x4*)(BSs + t * 128 + nb + 4 * i);
            const f32x4 cv = *(const LAS f32x4*)(CSs + t * 128 + nb + 4 * i);
            hs[i] = hs[i] * dec + bv * xv;
            yp += (hs[i][0] * cv[0] + hs[i][1] * cv[1]) + (hs[i][2] * cv[2] + hs[i][3] * cv[3]);
        }
        yp += __shfl_xor(yp, 1); yp += __shfl_xor(yp, 2); yp += __shfl_xor(yp, 4);
        if ((tid & 7) == 0) YS[t * 64 + p] = yp;
    }
    {
        float* so = a.out + O_SSMS + ((size_t)(b * 32 + h) * 64 + p) * 128 + nb;
#pragma unroll
        for (int i = 0; i < 4; ++i) *(f32x4*)(so + 4 * i) = hs[i];
    }
    __syncthreads();
    {
        const int t = w;
        const float y = YS[t * 64 + lane] + Dh * XS[t * 64 + lane];
        const float z = bf1(proj[(size_t)(r0 + t) * NPROJ + h * 64 + lane]);
        const float yv = y * silu_f(z);
        yg[(size_t)(r0 + t) * DI + h * 64 + lane] = (bf16_t)f2bf(yv);
        const float s = wave_sum(yv * yv);
        if (lane < 2) yss[(size_t)(r0 + t) * 64 + h * 2 + lane] = (lane == 0) ? s : 0.f;
    }
#undef a
}

__device__ __forceinline__ void phase_scan(LAS unsigned char* lds, int G, int bid) {
    for (int it = bid; it < 256; it += G) { __syncthreads(); scan_prompt_item(lds, it >> 5, it & 31); }
    for (int it = bid; it < 4096; it += G) { __syncthreads(); scan_sample_item(lds, it >> 5, it & 31); }
}

__device__ __forceinline__ void phase_ynorm(int G, int bid) {
    const KArgs ap = kargs();
#define a (*ap)
    bf16_t* yg = (bf16_t*)(a.ws + WS_YG); const float* yss = (const float*)(a.ws + WS_YSS);
    const int total = MT * 256;
    int tid_ = threadIdx.x; asm volatile("" : "+v"(tid_));
    for (int idx = bid * NTHR + tid_; idx < total; idx += G * NTHR) {
        const int r = idx >> 8, cc = idx & 255, g = cc >> 5;
        const f32x4 s0 = *(const f32x4*)(yss + (size_t)r * 64 + g * 8), s1 = *(const f32x4*)(yss + (size_t)r * 64 + g * 8 + 4);
        const float ss = ((s0[0] + s0[1]) + (s0[2] + s0[3])) + ((s1[0] + s1[1]) + (s1[2] + s1[3]));
        const float rs = rsqrtf(ss * (1.0f / 256.0f) + EPS);
        u32x4* ptr = (u32x4*)(yg + (size_t)r * DI + cc * 8);
        const u32x4 v = *ptr; float f[8]; unpack8(v, f);
        u32x4 o; o.x = cvt_pk_bf16(f[0] * rs, f[1] * rs); o.y = cvt_pk_bf16(f[2] * rs, f[3] * rs); o.z = cvt_pk_bf16(f[4] * rs, f[5] * rs); o.w = cvt_pk_bf16(f[6] * rs, f[7] * rs);
        *ptr = o;
    }
#undef a
}

__device__ __forceinline__ void phase_poolstats(int G, int bid) {
    const KArgs ap = kargs();
#define a (*ap)
    const bf16_t* ub = (const bf16_t*)(a.ws + WS_R1);
    bf16_t* mixed = (bf16_t*)(a.ws + WS_R1 + (size_t)MT * DM * 2);
    const float* spool = a.in[4];
    const int total = MT * 128;
    int tid_ = threadIdx.x; asm volatile("" : "+v"(tid_));
    for (int idx = bid * NTHR + tid_; idx < total; idx += G * NTHR) {
        const int r = idx >> 7, cc = idx & 127, c0 = cc * 8, k = cc >> 5, wlen = 2 << k;
        float sum[8] = {0.f, 0.f, 0.f, 0.f, 0.f, 0.f, 0.f, 0.f}; float own[8]; float cnt;
        {
            const u32x4 v = *(const u32x4*)(ub + (size_t)r * DM + c0); unpack8(v, own);
        }
        if (r < MP) {
            const int t = r & 2047; const int n = (t + 1 < wlen) ? (t + 1) : wlen; cnt = (float)n;
            for (int i = 0; i < n; ++i) { const u32x4 v = *(const u32x4*)(ub + (size_t)(r - i) * DM + c0); float f[8]; unpack8(v, f);
#pragma unroll
                for (int e = 0; e < 8; ++e) sum[e] += f[e]; }
        } else {
            const int q = r - MP, bb = q >> 3, t = q & 7; cnt = (float)wlen;
            for (int i = 0; i < wlen; ++i) {
                const int e_ = 15 + t - i;
                if (e_ >= 15) { const u32x4 v = *(const u32x4*)(ub + (size_t)(MP + bb * 8 + (e_ - 15)) * DM + c0); float f[8]; unpack8(v, f);
#pragma unroll
                    for (int e = 0; e < 8; ++e) sum[e] += f[e]; }
                else { const float* sp = spool + ((size_t)bb * 15 + e_) * 1024 + c0; const f32x4 v0 = *(const f32x4*)sp, v1 = *(const f32x4*)(sp + 4);
#pragma unroll
                    for (int e = 0; e < 4; ++e) { sum[e] += v0[e]; sum[4 + e] += v1[e]; } }
            }
        }
        const float inv = 1.0f / cnt;
        u32x4 o; o.x = cvt_pk_bf16(sum[0] * inv - own[0], sum[1] * inv - own[1]); o.y = cvt_pk_bf16(sum[2] * inv - own[2], sum[3] * inv - own[3]);
        o.z = cvt_pk_bf16(sum[4] * inv - own[4], sum[5] * inv - own[5]); o.w = cvt_pk_bf16(sum[6] * inv - own[6], sum[7] * inv - own[7]);
        *(u32x4*)(mixed + (size_t)r * DM + c0) = o;
    }
    float* pools = a.out + O_POOLS;
    const int tot2 = 128 * 7 * 256;
    for (int idx = bid * NTHR + tid_; idx < tot2; idx += G * NTHR) {
        const int c4 = idx & 255, j = (idx >> 8) % 7, bb = idx / (7 * 256);
        *(f32x4*)(pools + ((size_t)bb * 15 + j) * 1024 + c4 * 4) = *(const f32x4*)(spool + ((size_t)bb * 15 + 8 + j) * 1024 + c4 * 4);
    }
#undef a
}

__device__ __forceinline__ void phase_final(int G, int bid) {
    const KArgs ap = kargs();
#define a (*ap)
    const float* xres = (const float*)(a.ws + WS_XRES); const float* ssq = (const float*)(a.ws + WS_SSQ); const float* gn = a.in[22];
    float* y = a.out + O_Y;
    const int total = MT * 256;
    int tid_ = threadIdx.x; asm volatile("" : "+v"(tid_));
    for (int idx = bid * NTHR + tid_; idx < total; idx += G * NTHR) {
        const int r = idx >> 8, c4 = idx & 255;
        const float* sp = ssq + (size_t)r * 16;
        const f32x4 q0 = *(const f32x4*)sp, q1 = *(const f32x4*)(sp + 4), q2 = *(const f32x4*)(sp + 8), q3 = *(const f32x4*)(sp + 12);
        const float ss = (((q0[0] + q0[1]) + (q0[2] + q0[3])) + ((q1[0] + q1[1]) + (q1[2] + q1[3]))) + (((q2[0] + q2[1]) + (q2[2] + q2[3])) + ((q3[0] + q3[1]) + (q3[2] + q3[3])));
        const float rs = rsqrtf(ss * (1.0f / 1024.0f) + EPS);
        const f32x4 v = *(const f32x4*)(xres + (size_t)r * DM + c4 * 4), gg = *(const f32x4*)(gn + c4 * 4);
        *(f32x4*)(y + (size_t)r * DM + c4 * 4) = v * rs * gg;
    }
#undef a
}

__device__ __forceinline__ void run_ffn_up(LAS unsigned char* lds, int f, int G, int bid) {
    const KArgs ap = kargs(); unsigned char* ws = ap->ws;
    EpiSwiGLU e; e.act = (bf16_t*)(ws + WS_R1); e.ssq = (const float*)(ws + WS_SSQ);
    Order S; S.init(MT / BM, 5632 / BM, G, bid);
    gemm_phase(lds, (const bf16_t*)(ws + WS_XB), DM, 0, (const bf16_t*)(ws + WS_WGU) + (size_t)f * 5632 * 1024, DM, S, e);
}
__device__ __forceinline__ void run_resid(LAS unsigned char* lds, int which, int f, int G, int bid) {
    const KArgs ap = kargs(); unsigned char* ws = ap->ws;
    float* xres = (float*)(ws + WS_XRES);
    EpiResid e; e.rin0 = xres; e.rin1 = xres; e.rout = xres; e.xb = (bf16_t*)(ws + WS_XB); e.ssq = (float*)(ws + WS_SSQ); e.scale = (which == 0) ? 0.5f : 1.0f;
    if (which == 0 && f == 0) { e.rin0 = ap->in[0]; e.rin1 = ap->in[1] - (size_t)MP * DM; }
    const bf16_t* A; const bf16_t* Bt; int K;
    if (which == 0) { A = (const bf16_t*)(ws + WS_R1); Bt = (const bf16_t*)(ws + WS_WD) + (size_t)f * 1024 * 2816; K = FF; }
    else if (which == 1) { A = (const bf16_t*)(ws + WS_YG); Bt = (const bf16_t*)(ws + WS_WOUT); K = DI; }
    else { A = (const bf16_t*)(ws + WS_R1) + (size_t)2 * MT * DM; Bt = (const bf16_t*)(ws + WS_WPOUT); K = DM; }
    Order S; S.init(MT / BM, DM / BM, G, bid);
    gemm_phase(lds, A, K, 0, Bt, K, S, e);
}
__device__ __forceinline__ void run_proj(LAS unsigned char* lds, int G, int bid) {
    const KArgs ap = kargs(); unsigned char* ws = ap->ws;
    EpiProj e; e.proj = (bf16_t*)(ws + WS_R1); e.dtraw = (float*)(ws + WS_DT); e.ssq = (const float*)(ws + WS_SSQ); e.convp = ap->out + O_CONVP; e.convs = ap->out + O_CONVS;
    Order S; S.init(MT / BM, NINP / BM, G, bid);
    gemm_phase(lds, (const bf16_t*)(ws + WS_XB), DM, 0, (const bf16_t*)(ws + WS_WIN), DM, S, e);
}
__device__ __forceinline__ void run_poolin(LAS unsigned char* lds, int G, int bid) {
    const KArgs ap = kargs(); unsigned char* ws = ap->ws;
    EpiPoolIn e; e.ub = (bf16_t*)(ws + WS_R1); e.ssq = (const float*)(ws + WS_SSQ); e.poolp = ap->out + O_POOLP; e.pools = ap->out + O_POOLS;
    Order S; S.init(MT / BM, DM / BM, G, bid);
    gemm_phase(lds, (const bf16_t*)(ws + WS_XB), DM, 0, (const bf16_t*)(ws + WS_WPIN), DM, S, e);
}
__device__ __forceinline__ void run_poolgrp(LAS unsigned char* lds, int G, int bid) {
    const KArgs ap = kargs(); unsigned char* ws = ap->ws;
    bf16_t* ub = (bf16_t*)(ws + WS_R1);
    EpiBf16 e; e.O = ub + (size_t)2 * MT * DM; e.ldc = DM;
    Order S; S.init(MT / BM, DM / BM, G, bid);
    gemm_phase(lds, ub + (size_t)MT * DM, DM, 256, (const bf16_t*)(ws + WS_WPG), 256, S, e);
}

__global__ void __launch_bounds__(NTHR, 2) fwd_megakernel(Args a_unused) {
    extern __shared__ __attribute__((aligned(16))) unsigned char lds_raw[];
    LAS unsigned char* lds = (LAS unsigned char*)lds_raw;
    cg::grid_group grid = cg::this_grid();
    const int G = gridDim.x, bid = blockIdx.x;

    phase_prep(lds, G, bid);
    grid.sync();
#pragma unroll 1
    for (int f = 0; f < 4; ++f) {
        run_ffn_up(lds, f, G, bid);
        grid.sync();
        run_resid(lds, 0, f, G, bid);
        grid.sync();
        if (f == 0) {
            run_proj(lds, G, bid);
            grid.sync();
            phase_scan(lds, G, bid);
            grid.sync();
            phase_ynorm(G, bid);
            grid.sync();
            run_resid(lds, 1, f, G, bid);
            grid.sync();
        }
        if (f == 2) {
            run_poolin(lds, G, bid);
            grid.sync();
            phase_poolstats(G, bid);
            grid.sync();
            run_poolgrp(lds, G, bid);
            grid.sync();
            run_resid(lds, 2, f, G, bid);
            grid.sync();
        }
    }
    phase_final(G, bid);
}

extern "C" void kernel_launch(void* const* d_in, const int* in_sizes, int n_in, void* d_out, int out_size, void* d_ws, size_t ws_size, hipStream_t stream) {
    static int grid_blocks = 0;
    if (grid_blocks == 0) {
        if (n_in != 23 || ws_size < WS_END) { fprintf(stderr, "kernel_launch: need 23 inputs and %zu B of workspace (got %d, %zu)\n", (size_t)WS_END, n_in, ws_size); grid_blocks = -1; return; }
        int dev = 0, cus = 0, per_cu = 0;
        (void)hipGetDevice(&dev);
        (void)hipDeviceGetAttribute(&cus, hipDeviceAttributeMultiprocessorCount, dev);
        if (hipFuncSetAttribute((const void*)fwd_megakernel, hipFuncAttributeMaxDynamicSharedMemorySize, LDS_BYTES) != hipSuccess) { fprintf(stderr, "kernel_launch: hipFuncSetAttribute failed\n"); }
        if (hipOccupancyMaxActiveBlocksPerMultiprocessor(&per_cu, (const void*)fwd_megakernel, NTHR, LDS_BYTES) != hipSuccess || per_cu < 1) { fprintf(stderr, "kernel_launch: occupancy query gave %d\n", per_cu); per_cu = 1; }
        (void)hipGetLastError();
        if (per_cu > 1) per_cu = 1;
        grid_blocks = cus * per_cu;
    }
    if (grid_blocks < 0) return;
    Args a{};
    for (int i = 0; i < 23; ++i) a.in[i] = (const float*)d_in[i];
    a.out = (float*)d_out; a.ws = (unsigned char*)d_ws;
    void* args[] = {&a};
    hipError_t e = hipLaunchCooperativeKernel((const void*)fwd_megakernel, dim3(grid_blocks), dim3(NTHR), args, LDS_BYTES, stream);
    if (e != hipSuccess) fprintf(stderr, "cooperative launch failed: %s (grid %d)\n", hipGetErrorString(e), grid_blocks);
}
```

```cpp
#include <hip/hip_runtime.h>
#include <hip/hip_cooperative_groups.h>
#include <cstdio>
namespace cg = cooperative_groups;

#define LAS __attribute__((address_space(3)))
typedef unsigned short bf16_t;
typedef short bf16x8 __attribute__((ext_vector_type(8)));
typedef float f32x4 __attribute__((ext_vector_type(4)));
typedef unsigned u32x4 __attribute__((ext_vector_type(4)));
typedef unsigned u32x2 __attribute__((ext_vector_type(2)));

constexpr int MP = 16384, MS = 1024, MT = MP + MS;
constexpr int DM = 1024, FF = 2816, DI = 2048, NPROJ = 6144, NINP = 6400, NIN = 6176;
constexpr float EPS = 1e-6f;
constexpr int NTHR = 512;
constexpr int LDS_BYTES = 131072;

constexpr size_t WS_WGU = 0;
constexpr size_t WS_WD = WS_WGU + (size_t)4 * 5632 * 1024 * 2;
constexpr size_t WS_WIN = WS_WD + (size_t)4 * 1024 * 2816 * 2;
constexpr size_t WS_WOUT = WS_WIN + (size_t)NINP * 1024 * 2;
constexpr size_t WS_WPIN = WS_WOUT + (size_t)1024 * 2048 * 2;
constexpr size_t WS_WPG = WS_WPIN + (size_t)1024 * 1024 * 2;
constexpr size_t WS_WPOUT = WS_WPG + (size_t)1024 * 256 * 2;
constexpr size_t WS_XRES = WS_WPOUT + (size_t)1024 * 1024 * 2;
constexpr size_t WS_XB = WS_XRES + (size_t)MT * 1024 * 4;
constexpr size_t WS_SSQ = WS_XB + (size_t)MT * 1024 * 2;
constexpr size_t WS_YSS = WS_SSQ + (size_t)MT * 16 * 4;
constexpr size_t WS_DT = WS_YSS + (size_t)MT * 64 * 4;
constexpr size_t WS_YG = WS_DT + (size_t)MT * 32 * 4;
constexpr size_t WS_R1 = WS_YG + (size_t)MT * 2048 * 2;
constexpr size_t WS_HALO = WS_R1 + (size_t)MT * NPROJ * 2;
constexpr size_t WS_END = WS_HALO + (size_t)8 * 32 * 3 * 4096 * 2;

constexpr size_t O_Y = 0;
constexpr size_t O_SSMP = (size_t)MT * 1024;
constexpr size_t O_CONVP = O_SSMP + (size_t)8 * 32 * 64 * 128;
constexpr size_t O_POOLP = O_CONVP + (size_t)8 * 3 * 4096;
constexpr size_t O_SSMS = O_POOLP + (size_t)8 * 15 * 1024;
constexpr size_t O_CONVS = O_SSMS + (size_t)128 * 32 * 64 * 128;
constexpr size_t O_POOLS = O_CONVS + (size_t)128 * 3 * 4096;

struct Args { const float* in[23]; float* out; unsigned char* ws; };
typedef const __attribute__((address_space(4))) Args* KArgs;
__device__ __forceinline__ KArgs kargs() { KArgs p = (KArgs)__builtin_amdgcn_kernarg_segment_ptr(); asm volatile("" : "+s"(p)); return p; }

__device__ __forceinline__ unsigned f2bf(float f) { unsigned u = __float_as_uint(f); u += 0x7FFFu + ((u >> 16) & 1u); return u >> 16; }
__device__ __forceinline__ unsigned pk2(float lo, float hi) { return f2bf(lo) | (f2bf(hi) << 16); }
__device__ __forceinline__ unsigned cvt_pk_bf16(float lo, float hi) { unsigned r; asm volatile("v_cvt_pk_bf16_f32 %0, %1, %2" : "=v"(r) : "v"(lo), "v"(hi)); return r; }
__device__ __forceinline__ float bflo(unsigned w) { return __uint_as_float(w << 16); }
__device__ __forceinline__ float bfhi(unsigned w) { return __uint_as_float(w & 0xffff0000u); }
__device__ __forceinline__ float bf1(bf16_t v) { return __uint_as_float(((unsigned)v) << 16); }
__device__ __forceinline__ float silu_f(float v) { return v * __builtin_amdgcn_rcpf(1.0f + __expf(-v)); }
__device__ __forceinline__ float wave_sum(float v) {
#pragma unroll
    for (int o = 1; o < 64; o <<= 1) v += __shfl_xor(v, o);
    return v;
}
#define LDS_WAIT() asm volatile("s_waitcnt lgkmcnt(0)" ::: "memory")

constexpr int BM = 256, BK = 64, HALF = 128, HTB = HALF * BK * 2, NXCD = 8, WGM = 8;
__device__ __forceinline__ int lds_byte(int r, int c) { const int st = (r >> 4) * 2 + (c >> 5), rr = r & 15, cc = c & 31, ob = rr * 64 + cc * 2; return st * 1024 + (ob ^ (((ob >> 9) & 1) << 5)); }
__device__ __forceinline__ void stage_rc(int b, int& R, int& C) { const int st = b / 1024, sb = b % 1024, swz = sb ^ (((sb >> 9) & 1) << 5); R = (st >> 1) * 16 + swz / 64; C = (st & 1) * 32 + (swz % 64) / 2; }
__device__ __forceinline__ int perm32(int rho) { const int n = rho >> 4, i = rho & 15; return 8 * (i >> 2) + 4 * n + (i & 3); }

struct Unit { int pm, pn; };
struct Order {
    int nM, nN, nwg, G, c;
    __device__ __forceinline__ void init(int nM_, int nN_, int G_, int c_) { nM = nM_; nN = nN_; nwg = nM * nN; G = G_; c = c_; }
    __device__ __forceinline__ bool next(int i, Unit& u) const {
        const long L = (long)i * G + c; if (L >= nwg) return false;
        int wgid = (int)L; { const int q = nwg / NXCD, r = nwg % NXCD, xcd = wgid % NXCD, off = wgid / NXCD; wgid = (xcd < r ? xcd * (q + 1) : r * (q + 1) + (xcd - r) * q) + off; }
        const int nig = WGM * nN, gid = wgid / nig, fm = gid * WGM, gsz = (nM - fm) < WGM ? (nM - fm) : WGM;
        u.pm = fm + ((wgid % nig) % gsz); u.pn = (wgid % nig) / gsz; return true;
    }
};

template <class Epi>
__device__ __forceinline__ void gemm_phase(LAS unsigned char* lds, const bf16_t* A, int lda, int a_pn_off, const bf16_t* Bt, int K, const Order& S, const Epi& E) {
    int tid_ = threadIdx.x; asm volatile("" : "+v"(tid_));
    const int tid = tid_, wid = __builtin_amdgcn_readfirstlane(tid >> 6), lane = tid & 63, wr = wid >> 2, wc = wid & 3, fr = lane & 15, fq = lane >> 4;
    const int nt = K / BK;
    unsigned voffA[2], voffB[2];
#pragma unroll
    for (int i = 0; i < 2; ++i) { int R, C; stage_rc(tid * 16 + i * 8192, R, C); const int Rb = Epi::PERM ? ((R & ~31) + perm32(R & 31)) : R;
        voffA[i] = (unsigned)(R * lda + C) * 2u; voffB[i] = (unsigned)(Rb * K + C) * 2u; }
    const size_t kstep = (size_t)(BK * 2);
    const size_t hstepA = (size_t)HALF * lda * 2, hstepB = (size_t)HALF * K * 2;
    const size_t tstepA = 2 * hstepA, tstepB = 2 * hstepB;
    const unsigned ldsw = (unsigned)wid * 1024u;
    const int aoff = lds_byte(wr * 64 + fr, fq * 8), boff = lds_byte(wc * 32 + fr, fq * 8);
#define PG8_SA(b, h) (((b) * 2 + (h)) * HTB)
#define PG8_SB(b, h) ((4 + (b) * 2 + (h)) * HTB)
#define PG8_STAGE(bufoff, gbase, voff) do { _Pragma("unroll") for (int _i = 0; _i < 2; ++_i) \
        __builtin_amdgcn_global_load_lds((const unsigned*)((const char*)(gbase) + (voff)[_i]), (LAS unsigned*)(lds + (bufoff) + ldsw + _i * 8192), 16, 0, 0); } while (0)
#define PG8_LDA(dst, b, h) do { _Pragma("unroll") for (int m = 0; m < 4; ++m) _Pragma("unroll") for (int k = 0; k < 2; ++k) dst[m][k] = *(const LAS bf16x8*)(lds + PG8_SA(b, h) + aoff + m * 2048 + k * 1024); } while (0)
#define PG8_LDB(dst, b, h) do { _Pragma("unroll") for (int n = 0; n < 2; ++n) _Pragma("unroll") for (int k = 0; k < 2; ++k) dst[n][k] = *(const LAS bf16x8*)(lds + PG8_SB(b, h) + boff + n * 2048 + k * 1024); } while (0)
#define PG8_MMA(ai, bj, At, Bt_) do { __builtin_amdgcn_s_setprio(1); _Pragma("unroll") for (int m = 0; m < 4; ++m) _Pragma("unroll") for (int n = 0; n < 2; ++n) _Pragma("unroll") for (int k = 0; k < 2; ++k) \
        acc[ai][bj][m][n] = __builtin_amdgcn_mfma_f32_16x16x32_bf16(Bt_[n][k], At[m][k], acc[ai][bj][m][n], 0, 0, 0); __builtin_amdgcn_s_setprio(0); } while (0)
#define PG8_WAIT_V(n) asm volatile("s_waitcnt vmcnt(" #n ")" ::: "memory")
#define PG8_WAIT_L(n) asm volatile("s_waitcnt lgkmcnt(" #n ")" ::: "memory")
#define PG8_BAR __builtin_amdgcn_s_barrier()
#define PG8_SCHED __builtin_amdgcn_sched_barrier(0)
    Unit cur, nxt; int ui = 0;
    if (!S.next(0, cur)) return;
    f32x4 acc[2][2][4][2];
#pragma unroll
    for (int a = 0; a < 2; ++a)
#pragma unroll
        for (int b = 0; b < 2; ++b)
#pragma unroll
            for (int m = 0; m < 4; ++m)
#pragma unroll
                for (int n = 0; n < 2; ++n) acc[a][b][m][n] = (f32x4){0.f, 0.f, 0.f, 0.f};
    bf16x8 At[4][2], B0[2][2], B1[2][2];
    const char* cA = (const char*)A + (size_t)cur.pm * tstepA + (size_t)cur.pn * a_pn_off * 2; const char* cB = (const char*)Bt + (size_t)cur.pn * tstepB;
    PG8_STAGE(PG8_SB(0, 0), cB, voffB); PG8_STAGE(PG8_SA(0, 0), cA, voffA); PG8_STAGE(PG8_SB(0, 1), cB + hstepB, voffB); PG8_STAGE(PG8_SA(0, 1), cA + hstepA, voffA);
    if (wr == 1) PG8_BAR;
    PG8_WAIT_V(4); PG8_BAR;
    PG8_STAGE(PG8_SB(1, 0), cB + kstep, voffB); PG8_STAGE(PG8_SA(1, 0), cA + kstep, voffA); PG8_STAGE(PG8_SB(1, 1), cB + hstepB + kstep, voffB);
    PG8_WAIT_V(6); PG8_BAR;
    for (;;) {
        const bool has_next = S.next(ui + 1, nxt);
        const char* nA = has_next ? (const char*)A + (size_t)nxt.pm * tstepA + (size_t)nxt.pn * a_pn_off * 2 : cA; const char* nB = has_next ? (const char*)Bt + (size_t)nxt.pn * tstepB : cB;
        for (int t = 0; t < nt; t += 2) {
            const bool last = (t == nt - 2);
            const char* a1 = cA + (size_t)(t + 1) * kstep;
            const char* a2 = last ? nA : cA + (size_t)(t + 2) * kstep; const char* b2 = last ? nB : cB + (size_t)(t + 2) * kstep;
            const char* a3 = a2 + kstep; const char* b3 = b2 + kstep;
            PG8_LDB(B0, 0, 0); PG8_SCHED; PG8_LDA(At, 0, 0); PG8_STAGE(PG8_SA(1, 1), a1 + hstepA, voffA);
            PG8_WAIT_L(8); PG8_BAR; PG8_WAIT_L(0); PG8_MMA(0, 0, At, B0); PG8_BAR; PG8_SCHED;
            PG8_LDB(B1, 0, 1); PG8_STAGE(PG8_SB(0, 0), b2, voffB);
            PG8_BAR; PG8_WAIT_L(0); PG8_MMA(0, 1, At, B1); PG8_BAR;
            PG8_LDA(At, 0, 1); PG8_STAGE(PG8_SA(0, 0), a2, voffA);
            PG8_BAR; PG8_WAIT_L(0); PG8_MMA(1, 0, At, B0); PG8_BAR; PG8_SCHED;
            PG8_STAGE(PG8_SB(0, 1), b2 + hstepB, voffB);
            PG8_WAIT_V(6); PG8_BAR; PG8_MMA(1, 1, At, B1); PG8_BAR;
            PG8_LDB(B0, 1, 0); PG8_SCHED; PG8_LDA(At, 1, 0); PG8_STAGE(PG8_SA(0, 1), a2 + hstepA, voffA);
            PG8_WAIT_L(8); PG8_BAR; PG8_WAIT_L(0); PG8_MMA(0, 0, At, B0); PG8_BAR; PG8_SCHED;
            PG8_LDB(B1, 1, 1); PG8_STAGE(PG8_SB(1, 0), b3, voffB);
            PG8_BAR; PG8_WAIT_L(0); PG8_MMA(0, 1, At, B1); PG8_BAR;
            PG8_LDA(At, 1, 1); PG8_STAGE(PG8_SA(1, 0), a3, voffA);
            PG8_BAR; PG8_WAIT_L(0); PG8_MMA(1, 0, At, B0); PG8_BAR; PG8_SCHED;
            PG8_STAGE(PG8_SB(1, 1), b3 + hstepB, voffB);
            PG8_WAIT_V(6); PG8_BAR; PG8_MMA(1, 1, At, B1); PG8_BAR;
        }
        E(acc, cur, wr, wc, fr, fq);
        if (!has_next) break;
#pragma unroll
        for (int a = 0; a < 2; ++a)
#pragma unroll
            for (int b = 0; b < 2; ++b)
#pragma unroll
                for (int m = 0; m < 4; ++m)
#pragma unroll
                    for (int n = 0; n < 2; ++n) acc[a][b][m][n] = (f32x4){0.f, 0.f, 0.f, 0.f};
        cur = nxt; cA = nA; cB = nB; ++ui;
    }
    PG8_WAIT_V(0);
    if (wr == 0) PG8_BAR;
    PG8_BAR;
#undef PG8_SA
#undef PG8_SB
#undef PG8_STAGE
#undef PG8_LDA
#undef PG8_LDB
#undef PG8_MMA
#undef PG8_WAIT_V
#undef PG8_WAIT_L
#undef PG8_BAR
#undef PG8_SCHED
}

__device__ __forceinline__ float row_rstd(const float* ssq, int r, int fq) {
    const f32x4 q = *(const f32x4*)(ssq + (size_t)r * 16 + fq * 4);
    float s = (q[0] + q[1]) + (q[2] + q[3]);
    s += __shfl_xor(s, 16); s += __shfl_xor(s, 32);
    return rsqrtf(s * (1.0f / 1024.0f) + EPS);
}

__device__ __forceinline__ void row_rstd8(const float* ssq, int row0, int fq, float (&rs)[8]) {
    f32x4 q[8];
#pragma unroll
    for (int i = 0; i < 8; ++i) q[i] = *(const f32x4*)(ssq + (size_t)(row0 + (i >> 2) * HALF + (i & 3) * 16) * 16 + fq * 4);
#pragma unroll
    for (int i = 0; i < 8; ++i) { float s = (q[i][0] + q[i][1]) + (q[i][2] + q[i][3]); s += __shfl_xor(s, 16); s += __shfl_xor(s, 32); rs[i] = rsqrtf(s * (1.0f / 1024.0f) + EPS); }
}

struct EpiSwiGLU {
    static constexpr bool PERM = true;
    bf16_t* act; const float* ssq;
    __device__ __forceinline__ void operator()(const f32x4 (&acc)[2][2][4][2], const Unit& u, int wr, int wc, int fr, int fq) const {
        const int row0 = u.pm * BM + wr * 64 + fr, col0 = u.pn * 128 + wc * 32 + 8 * fq;
        float rs8[8]; row_rstd8(ssq, row0, fq, rs8);
#pragma unroll
        for (int ai = 0; ai < 2; ++ai)
#pragma unroll
            for (int m = 0; m < 4; ++m) {
                const int r = row0 + ai * HALF + m * 16;
                const float rs = rs8[ai * 4 + m];
                float o[8];
#pragma unroll
                for (int n = 0; n < 2; ++n)
#pragma unroll
                    for (int j = 0; j < 4; ++j) { const float g = acc[ai][0][m][n][j] * rs, uu = acc[ai][1][m][n][j] * rs; o[n * 4 + j] = silu_f(g) * uu; }
                u32x4 w; w.x = cvt_pk_bf16(o[0], o[1]); w.y = cvt_pk_bf16(o[2], o[3]); w.z = cvt_pk_bf16(o[4], o[5]); w.w = cvt_pk_bf16(o[6], o[7]);
                *(u32x4*)(act + (size_t)r * FF + col0) = w;
            }
    }
};

struct EpiResid {
    static constexpr bool PERM = false;
    const float* rin0; const float* rin1; float* rout; bf16_t* xb; float* ssq; float scale;
    __device__ __forceinline__ void operator()(const f32x4 (&acc)[2][2][4][2], const Unit& u, int wr, int wc, int fr, int fq) const {
        const float* rin = (u.pm < 64) ? rin0 : rin1;
        const int row0 = u.pm * BM + wr * 64 + fr, col0 = u.pn * BM + wc * 32 + 4 * fq;
#pragma unroll
        for (int ai = 0; ai < 2; ++ai) {
            f32x4 rb[4][2][2];
#pragma unroll
            for (int m = 0; m < 4; ++m)
#pragma unroll
                for (int bj = 0; bj < 2; ++bj)
#pragma unroll
                    for (int n = 0; n < 2; ++n) rb[m][bj][n] = *(const f32x4*)(rin + (size_t)(row0 + ai * HALF + m * 16) * DM + col0 + bj * HALF + n * 16);
#pragma unroll
            for (int m = 0; m < 4; ++m) {
                const int r = row0 + ai * HALF + m * 16; const size_t off = (size_t)r * DM + col0; float ss = 0.f;
#pragma unroll
                for (int bj = 0; bj < 2; ++bj)
#pragma unroll
                    for (int n = 0; n < 2; ++n) {
                        const size_t c = off + bj * HALF + n * 16;
                        const f32x4 b = rb[m][bj][n];
                        const f32x4 o = b + acc[ai][bj][m][n] * scale;
                        *(f32x4*)(rout + c) = o;
                        u32x2 w; w.x = cvt_pk_bf16(o[0], o[1]); w.y = cvt_pk_bf16(o[2], o[3]);
                        *(u32x2*)(xb + c) = w;
                        ss += (o[0] * o[0] + o[1] * o[1]) + (o[2] * o[2] + o[3] * o[3]);
                    }
                ss += __shfl_xor(ss, 16); ss += __shfl_xor(ss, 32);
                if (fq == 0) ssq[(size_t)r * 16 + u.pn * 4 + wc] = ss;
            }
        }
    }
};

struct EpiProj {
    static constexpr bool PERM = true;
    bf16_t* proj; float* dtraw; const float* ssq; float* convp; float* convs; bf16_t* halo;
    __device__ __forceinline__ void operator()(const f32x4 (&acc)[2][2][4][2], const Unit& u, int wr, int wc, int fr, int fq) const {
        const int row0 = u.pm * BM + wr * 64 + fr, cb = u.pn * BM + wc * 32 + 8 * fq;
        float rs8[8]; row_rstd8(ssq, row0, fq, rs8);
#pragma unroll
        for (int ai = 0; ai < 2; ++ai)
#pragma unroll
            for (int m = 0; m < 4; ++m) {
                const int r = row0 + ai * HALF + m * 16;
                const float rs = rs8[ai * 4 + m];
                float* cdst = nullptr; bf16_t* hdst = nullptr;
                if (r < MP) { const int t = r & 2047; if (t >= 2045) cdst = convp + ((size_t)(r >> 11) * 3 + (t - 2045)) * 4096;
                    else if ((t & 63) >= 61) hdst = halo + (((size_t)(r >> 11) * 32 + (t >> 6) + 1) * 3 + ((t & 63) - 61)) * 4096; }
                else { const int q = r - MP, t = q & 7; if (t >= 5) cdst = convs + ((size_t)(q >> 3) * 3 + (t - 5)) * 4096; }
#pragma unroll
                for (int bj = 0; bj < 2; ++bj) {
                    const int c0 = cb + bj * HALF;
                    const f32x4 v0 = acc[ai][bj][m][0] * rs, v1 = acc[ai][bj][m][1] * rs;
                    if (c0 < NPROJ) {
                        u32x4 w; w.x = cvt_pk_bf16(v0[0], v0[1]); w.y = cvt_pk_bf16(v0[2], v0[3]); w.z = cvt_pk_bf16(v1[0], v1[1]); w.w = cvt_pk_bf16(v1[2], v1[3]);
                        *(u32x4*)(proj + (size_t)r * NPROJ + c0) = w;
                        if (c0 >= 2048 && cdst) { *(f32x4*)(cdst + (c0 - 2048)) = v0; *(f32x4*)(cdst + (c0 - 2048) + 4) = v1; }
                        if (c0 >= 2048 && hdst) *(u32x4*)(hdst + (c0 - 2048)) = w;
                    } else if (c0 < NIN) {
                        float* d = dtraw + (size_t)r * 32 + (c0 - NPROJ);
                        *(f32x4*)d = v0; *(f32x4*)(d + 4) = v1;
                    }
                }
            }
    }
};

struct EpiPoolIn {
    static constexpr bool PERM = true;
    bf16_t* ub; const float* ssq; float* poolp; float* pools;
    __device__ __forceinline__ void operator()(const f32x4 (&acc)[2][2][4][2], const Unit& u, int wr, int wc, int fr, int fq) const {
        const int row0 = u.pm * BM + wr * 64 + fr, cb = u.pn * BM + wc * 32 + 8 * fq;
        float rs8[8]; row_rstd8(ssq, row0, fq, rs8);
#pragma unroll
        for (int ai = 0; ai < 2; ++ai)
#pragma unroll
            for (int m = 0; m < 4; ++m) {
                const int r = row0 + ai * HALF + m * 16;
                const float rs = rs8[ai * 4 + m];
                float* pdst = nullptr;
                if (r < MP) { const int t = r & 2047; if (t >= 2033) pdst = poolp + ((size_t)(r >> 11) * 15 + (t - 2033)) * 1024; }
                else { const int q = r - MP, t = q & 7; pdst = pools + ((size_t)(q >> 3) * 15 + 7 + t) * 1024; }
#pragma unroll
                for (int bj = 0; bj < 2; ++bj) {
                    const int c0 = cb + bj * HALF;
                    const f32x4 v0 = acc[ai][bj][m][0] * rs, v1 = acc[ai][bj][m][1] * rs;
                    u32x4 w; w.x = cvt_pk_bf16(v0[0], v0[1]); w.y = cvt_pk_bf16(v0[2], v0[3]); w.z = cvt_pk_bf16(v1[0], v1[1]); w.w = cvt_pk_bf16(v1[2], v1[3]);
                    *(u32x4*)(ub + (size_t)r * DM + c0) = w;
                    if (pdst) { *(f32x4*)(pdst + c0) = v0; *(f32x4*)(pdst + c0 + 4) = v1; }
                }
            }
    }
};

struct EpiBf16 {
    static constexpr bool PERM = true;
    bf16_t* O; int ldc;
    __device__ __forceinline__ void operator()(const f32x4 (&acc)[2][2][4][2], const Unit& u, int wr, int wc, int fr, int fq) const {
        const int row0 = u.pm * BM + wr * 64 + fr, cb = u.pn * BM + wc * 32 + 8 * fq;
#pragma unroll
        for (int ai = 0; ai < 2; ++ai)
#pragma unroll
            for (int m = 0; m < 4; ++m) {
                const int r = row0 + ai * HALF + m * 16;
#pragma unroll
                for (int bj = 0; bj < 2; ++bj) {
                    const f32x4 v0 = acc[ai][bj][m][0], v1 = acc[ai][bj][m][1];
                    u32x4 w; w.x = cvt_pk_bf16(v0[0], v0[1]); w.y = cvt_pk_bf16(v0[2], v0[3]); w.z = cvt_pk_bf16(v1[0], v1[1]); w.w = cvt_pk_bf16(v1[2], v1[3]);
                    *(u32x4*)(O + (size_t)r * ldc + cb + bj * HALF) = w;
                }
            }
    }
};

__device__ __forceinline__ void transpose_item(const float* W, int ldw, const float* kscale, bf16_t* WT, int K, int k0, int n0, int drow0, LAS float* scr, int lane) {
#pragma unroll 8
    for (int i = 0; i < 32; ++i) { const int kk = 2 * i + (lane >> 5); float v = W[(size_t)(k0 + kk) * ldw + n0 + (lane & 31)]; if (kscale) v *= kscale[k0 + kk]; scr[kk * 33 + (lane & 31)] = v; }
    LDS_WAIT(); asm volatile("" ::: "memory");
    const int c = lane & 7;
#pragma unroll
    for (int j = 0; j < 4; ++j) { const int n = (lane >> 3) + 8 * j; const LAS float* s = scr + (8 * c) * 33 + n;
        u32x4 o; o.x = pk2(s[0 * 33], s[1 * 33]); o.y = pk2(s[2 * 33], s[3 * 33]); o.z = pk2(s[4 * 33], s[5 * 33]); o.w = pk2(s[6 * 33], s[7 * 33]);
        *(u32x4*)(WT + (size_t)(drow0 + n) * K + k0 + 8 * c) = o; }
    LDS_WAIT(); asm volatile("" ::: "memory");
}

__device__ __forceinline__ void phase_prep(LAS unsigned char* lds, int G, int bid) {
    const KArgs ap = kargs();
#define a (*ap)
    int tid_ = threadIdx.x; asm volatile("" : "+v"(tid_));
    const int tid = tid_, lane = tid & 63, wave = tid >> 6;
    LAS float* scr = (LAS float*)(lds + wave * 8448);
    const int gw = bid * 8 + wave, NGW = G * 8;
    unsigned char* ws = a.ws;
    constexpr int I_FF = 1408, N_FF = 12 * I_FF, I_IN = 16 * 193, I_OUT = 32 * 32, I_PIN = 512, I_PG = 128, I_POUT = 512;
    constexpr int NITEMS = N_FF + I_IN + I_OUT + I_PIN + I_PG + I_POUT;
    for (int it = gw; it < NITEMS; it += NGW) {
        int r = it;
        if (r < N_FF) {
            const int mat = r / I_FF, rr = r % I_FF, type = mat >> 2, f = mat & 3;
            if (type < 2) {
                const int kb = rr / 88, nb = rr % 88, n0 = nb * 32;
                const float* W = (type == 0 ? a.in[6] : a.in[7]) + (size_t)f * 1024 * 2816;
                transpose_item(W, 2816, a.in[5] + f * 1024, (bf16_t*)(ws + WS_WGU) + (size_t)f * 5632 * 1024, 1024, kb * 64, n0, (n0 >> 7) * 256 + (n0 & 127) + type * 128, scr, lane);
            } else {
                const int kb = rr / 32, nb = rr % 32;
                transpose_item(a.in[8] + (size_t)f * 2816 * 1024, 1024, nullptr, (bf16_t*)(ws + WS_WD) + (size_t)f * 1024 * 2816, 2816, kb * 64, nb * 32, nb * 32, scr, lane);
            }
            continue;
        }
        r -= N_FF;
        if (r < I_IN) { const int kb = r / 193, nb = r % 193; transpose_item(a.in[10], NIN, a.in[9], (bf16_t*)(ws + WS_WIN), 1024, kb * 64, nb * 32, nb * 32, scr, lane); continue; }
        r -= I_IN;
        if (r < I_OUT) { const int kb = r / 32, nb = r % 32; transpose_item(a.in[17], 1024, a.in[16], (bf16_t*)(ws + WS_WOUT), 2048, kb * 64, nb * 32, nb * 32, scr, lane); continue; }
        r -= I_OUT;
        if (r < I_PIN) { const int kb = r / 32, nb = r % 32; transpose_item(a.in[18], 1024, a.in[9] + 1024, (bf16_t*)(ws + WS_WPIN), 1024, kb * 64, nb * 32, nb * 32, scr, lane); continue; }
        r -= I_PIN;
        if (r < I_PG) { const int g = r >> 5, rr = r & 31, kb = rr >> 3, nb = rr & 7; transpose_item(a.in[19] + (size_t)g * 65536, 256, nullptr, (bf16_t*)(ws + WS_WPG), 256, kb * 64, nb * 32, g * 256 + nb * 32, scr, lane); continue; }
        r -= I_PG;
        { const int kb = r / 32, nb = r % 32; transpose_item(a.in[21], 1024, a.in[20], (bf16_t*)(ws + WS_WPOUT), 1024, kb * 64, nb * 32, nb * 32, scr, lane); }
    }
    {
        u32x4* z = (u32x4*)((bf16_t*)(ws + WS_WIN) + (size_t)NIN * 1024);
        const int nz = (NINP - NIN) * 1024 / 8;
        for (int i = bid * NTHR + tid; i < nz; i += G * NTHR) z[i] = (u32x4){0u, 0u, 0u, 0u};
    }
    bf16_t* xb = (bf16_t*)(ws + WS_XB); float* ssq = (float*)(ws + WS_SSQ);
    for (int row = gw; row < MT; row += NGW) {
        const float* xr = (row < MP) ? a.in[0] + (size_t)row * DM : a.in[1] + (size_t)(row - MP) * DM;
        float s = 0.f;
#pragma unroll
        for (int j = 0; j < 4; ++j) {
            const f32x4 v = *(const f32x4*)(xr + 4 * lane + 256 * j);
            s += (v[0] * v[0] + v[1] * v[1]) + (v[2] * v[2] + v[3] * v[3]);
            u32x2 w; w.x = cvt_pk_bf16(v[0], v[1]); w.y = cvt_pk_bf16(v[2], v[3]);
            *(u32x2*)(xb + (size_t)row * DM + 4 * lane + 256 * j) = w;
        }
        s = wave_sum(s);
        if (lane < 16) ssq[(size_t)row * 16 + lane] = (lane == 0) ? s : 0.f;
    }
#undef a
}

constexpr int SX = 72, SW = 136;
constexpr int L_XT = 0;
constexpr int L_BS = L_XT + 64 * SX * 2;
constexpr int L_CS = L_BS + 64 * SW * 2;
constexpr int L_BWT = L_CS + 64 * SW * 2;
constexpr int L_LS = L_BWT + 128 * SX * 2;
constexpr int L_HB = L_LS + 64 * SX * 2;
constexpr int L_ZS = L_HB + 64 * SW * 2;
constexpr int L_DT = L_ZS + 64 * SX * 2;
constexpr int L_AC = L_DT + 256;
constexpr int L_SCAN_END = L_AC + 256;
static_assert(L_SCAN_END <= LDS_BYTES, "scan LDS");

__device__ __forceinline__ f32x4 mfma16(bf16x8 a, bf16x8 b, f32x4 c) { return __builtin_amdgcn_mfma_f32_16x16x32_bf16(a, b, c, 0, 0, 0); }

__device__ __forceinline__ void unpack8(const u32x4 w, float (&o)[8]) {
    o[0] = bflo(w.x); o[1] = bfhi(w.x); o[2] = bflo(w.y); o[3] = bfhi(w.y); o[4] = bflo(w.z); o[5] = bfhi(w.z); o[6] = bflo(w.w); o[7] = bfhi(w.w);
}

__device__ __forceinline__ void lds_barrier() { asm volatile("s_waitcnt lgkmcnt(0)" ::: "memory"); __builtin_amdgcn_s_barrier(); asm volatile("" ::: "memory"); }

__device__ __forceinline__ void phase_conv(int G, int bid) {
    const KArgs ap = kargs();
    int tid_ = threadIdx.x; asm volatile("" : "+v"(tid_));
    const int tid = tid_, cgl = tid & 127, seg = tid >> 7;
    unsigned char* ws = ap->ws;
    bf16_t* proj = (bf16_t*)(ws + WS_R1); const bf16_t* halo = (const bf16_t*)(ws + WS_HALO);
    const float* cwg = ap->in[11]; const float* cbg = ap->in[12];
#pragma unroll 1
    for (int item = bid; item < 1024; item += G) {
        const int tile = item >> 2, slab = item & 3, b = tile >> 5, ti = tile & 31;
        const int ch0 = slab * 1024 + cgl * 8;
        const size_t rowt = (size_t)b * 2048 + ti * 64;
        float cw[4][8], cbias[8];
#pragma unroll
        for (int k = 0; k < 4; ++k) { const f32x4 w0 = *(const f32x4*)(cwg + k * 4096 + ch0), w1 = *(const f32x4*)(cwg + k * 4096 + ch0 + 4);
#pragma unroll
            for (int e = 0; e < 4; ++e) { cw[k][e] = w0[e]; cw[k][4 + e] = w1[e]; } }
        { const f32x4 b0 = *(const f32x4*)(cbg + ch0), b1 = *(const f32x4*)(cbg + ch0 + 4);
#pragma unroll
            for (int e = 0; e < 4; ++e) { cbias[e] = b0[e]; cbias[4 + e] = b1[e]; } }
        u32x4 rows[19];
#pragma unroll
        for (int i = 0; i < 19; ++i) {
            const int trel = seg * 16 - 3 + i;
            if (trel >= 0) rows[i] = *(const u32x4*)(proj + (rowt + trel) * NPROJ + 2048 + ch0);
            else if (ti > 0) rows[i] = *(const u32x4*)(halo + (((size_t)b * 32 + ti) * 3 + (trel + 3)) * 4096 + ch0);
            else rows[i] = (u32x4){0u, 0u, 0u, 0u};
        }
        __syncthreads();
        float p0[8], p1[8], p2[8];
        unpack8(rows[0], p0); unpack8(rows[1], p1); unpack8(rows[2], p2);
#pragma unroll
        for (int e = 0; e < 16; ++e) {
            float cur[8]; unpack8(rows[3 + e], cur);
            float y[8];
#pragma unroll
            for (int k = 0; k < 8; ++k) { const float v = cbias[k] + cw[0][k] * p0[k] + cw[1][k] * p1[k] + cw[2][k] * p2[k] + cw[3][k] * cur[k]; y[k] = silu_f(v); }
            u32x4 pk; pk.x = cvt_pk_bf16(y[0], y[1]); pk.y = cvt_pk_bf16(y[2], y[3]); pk.z = cvt_pk_bf16(y[4], y[5]); pk.w = cvt_pk_bf16(y[6], y[7]);
            *(u32x4*)(proj + (rowt + seg * 16 + e) * NPROJ + 2048 + ch0) = pk;
#pragma unroll
            for (int k = 0; k < 8; ++k) { p0[k] = p1[k]; p1[k] = p2[k]; p2[k] = cur[k]; }
        }
    }
}

__device__ __forceinline__ void scan_prompt_item(LAS unsigned char* lds, int b, int h) {
    const KArgs ap = kargs();
#define a (*ap)
    int tid_ = threadIdx.x; asm volatile("" : "+v"(tid_));
    const int tid = tid_, lane = tid & 63, w = __builtin_amdgcn_readfirstlane(tid >> 6), fr = lane & 15, fq = lane >> 4;
    const int g = h >> 2;
    unsigned char* ws = a.ws;
    const bf16_t* proj = (const bf16_t*)(ws + WS_R1);
    const float* dtraw = (const float*)(ws + WS_DT);
    bf16_t* yg = (bf16_t*)(ws + WS_YG); float* yss = (float*)(ws + WS_YSS);
    const int r0 = b * 2048;
    const float dtb = a.in[13][h], Ah = -__expf(a.in[14][h]), Dh = a.in[15][h];
    LAS bf16_t* XT = (LAS bf16_t*)(lds + L_XT); LAS bf16_t* BS = (LAS bf16_t*)(lds + L_BS); LAS bf16_t* CS = (LAS bf16_t*)(lds + L_CS);
    LAS bf16_t* BWT = (LAS bf16_t*)(lds + L_BWT); LAS bf16_t* LS = (LAS bf16_t*)(lds + L_LS); LAS bf16_t* HB = (LAS bf16_t*)(lds + L_HB);
    LAS bf16_t* ZS = (LAS bf16_t*)(lds + L_ZS); LAS float* DTS = (LAS float*)(lds + L_DT); LAS float* ACS = (LAS float*)(lds + L_AC);
    const int sx = tid >> 3, qx = tid & 7, sb = tid >> 4, qb = tid & 15;
    const bf16_t* px = proj + (size_t)(r0 + sx) * NPROJ + 2048 + h * 64 + qx * 8;
    const bf16_t* pz = proj + (size_t)(r0 + sx) * NPROJ + h * 64 + qx * 8;
    const bf16_t* pb = proj + (size_t)(r0 + sb) * NPROJ + 4096 + g * 128 + qb * 8;
    const float* pd = dtraw + (size_t)(r0 + lane) * 32 + h;
    u32x4 rx, rz, rb0, rb1, rc0, rc1; float rdt;
#define SCAN_ISSUE(c_) do { const size_t o_ = (size_t)(c_) * 64 * NPROJ; \
        rx = *(const u32x4*)(px + o_); rz = *(const u32x4*)(pz + o_); \
        rb0 = *(const u32x4*)(pb + o_); rb1 = *(const u32x4*)(pb + o_ + (size_t)32 * NPROJ); \
        rc0 = *(const u32x4*)(pb + o_ + 1024); rc1 = *(const u32x4*)(pb + o_ + (size_t)32 * NPROJ + 1024); \
        rdt = pd[(size_t)(c_) * 64 * 32]; } while (0)
    SCAN_ISSUE(0);
    for (int i = tid; i < 64 * SW / 2; i += NTHR) ((LAS unsigned*)HB)[i] = 0u;
    f32x4 hacc[4];
#pragma unroll
    for (int q = 0; q < 4; ++q) hacc[q] = (f32x4){0.f, 0.f, 0.f, 0.f};

#pragma unroll 1
    for (int c = 0; c < 32; ++c) {
        const int t0 = c * 64;
        {
            const float v = rdt + dtb;
            const float dtl = (v > 20.f) ? v : log1pf(__expf(v));
            float s = dtl * Ah;
#pragma unroll
            for (int o = 1; o < 64; o <<= 1) { const float n = __shfl_up(s, o); if (lane >= o) s += n; }
            const float tot = __shfl(s, 63);
            const float wgt = dtl * __expf(tot - s);
            if (w == 0) { DTS[lane] = dtl; ACS[lane] = s; }
            const float wb0 = __shfl(wgt, sb), wb1 = __shfl(wgt, sb + 32);
            {
                const unsigned xw[4] = {rx.x, rx.y, rx.z, rx.w};
#pragma unroll
                for (int k = 0; k < 4; ++k) { XT[(qx * 8 + 2 * k) * SX + sx] = (bf16_t)(xw[k] & 0xffffu); XT[(qx * 8 + 2 * k + 1) * SX + sx] = (bf16_t)(xw[k] >> 16); }
            }
            *(LAS u32x4*)(ZS + sx * SX + qx * 8) = rz;
            *(LAS u32x4*)(BS + sb * SW + qb * 8) = rb0; *(LAS u32x4*)(BS + (sb + 32) * SW + qb * 8) = rb1;
            *(LAS u32x4*)(CS + sb * SW + qb * 8) = rc0; *(LAS u32x4*)(CS + (sb + 32) * SW + qb * 8) = rc1;
            {
                float f0[8], f1[8]; unpack8(rb0, f0); unpack8(rb1, f1);
#pragma unroll
                for (int k = 0; k < 8; ++k) { BWT[(qb * 8 + k) * SX + sb] = (bf16_t)f2bf(f0[k] * wb0); BWT[(qb * 8 + k) * SX + sb + 32] = (bf16_t)f2bf(f1[k] * wb1); }
            }
        }
        { const int cn = (c + 1 < 32) ? (c + 1) : c; SCAN_ISSUE(cn); }
        lds_barrier();
        {
            const int lt = w >> 1;
#pragma unroll
            for (int q = 0; q < 2; ++q) {
                const int st = (w & 1) * 2 + q;
                f32x4 acc = (f32x4){0.f, 0.f, 0.f, 0.f};
                if (st <= lt) {
#pragma unroll
                    for (int kk = 0; kk < 4; ++kk) {
                        const bf16x8 av = *(const LAS bf16x8*)(CS + (lt * 16 + fr) * SW + kk * 32 + fq * 8);
                        const bf16x8 bv = *(const LAS bf16x8*)(BS + (st * 16 + fr) * SW + kk * 32 + fq * 8);
                        acc = mfma16(av, bv, acc);
                    }
                }
                const int s = st * 16 + fr; const float acs = ACS[s], dts = DTS[s];
#pragma unroll
                for (int j = 0; j < 4; ++j) {
                    const int l = lt * 16 + fq * 4 + j;
                    const float v = (s <= l) ? acc[j] * __expf(ACS[l] - acs) * dts : 0.f;
                    LS[l * SX + s] = (bf16_t)f2bf(v);
                }
            }
        }
        lds_barrier();
        {
            const int lt = w >> 1; float ssr[4] = {0.f, 0.f, 0.f, 0.f};
#pragma unroll
            for (int q = 0; q < 2; ++q) {
                const int pt = (w & 1) * 2 + q;
                f32x4 a1 = (f32x4){0.f, 0.f, 0.f, 0.f}, a2 = (f32x4){0.f, 0.f, 0.f, 0.f};
#pragma unroll
                for (int kk = 0; kk < 2; ++kk) {
                    const bf16x8 av = *(const LAS bf16x8*)(LS + (lt * 16 + fr) * SX + kk * 32 + fq * 8);
                    const bf16x8 bv = *(const LAS bf16x8*)(XT + (pt * 16 + fr) * SX + kk * 32 + fq * 8);
                    a1 = mfma16(av, bv, a1);
                }
#pragma unroll
                for (int kk = 0; kk < 4; ++kk) {
                    const bf16x8 av = *(const LAS bf16x8*)(CS + (lt * 16 + fr) * SW + kk * 32 + fq * 8);
                    const bf16x8 bv = *(const LAS bf16x8*)(HB + (pt * 16 + fr) * SW + kk * 32 + fq * 8);
                    a2 = mfma16(av, bv, a2);
                }
                const int p = pt * 16 + fr, l0 = lt * 16 + fq * 4;
                const u32x2 xw = *(const LAS u32x2*)(XT + p * SX + l0);
                const float xv[4] = {bflo(xw.x), bfhi(xw.x), bflo(xw.y), bfhi(xw.y)};
#pragma unroll
                for (int j = 0; j < 4; ++j) {
                    const int l = l0 + j;
                    const float y = a1[j] + __expf(ACS[l]) * a2[j] + Dh * xv[j];
                    const float z = bf1(ZS[l * SX + p]);
                    const float yv = y * silu_f(z);
                    yg[(size_t)(r0 + t0 + l) * DI + h * 64 + p] = (bf16_t)f2bf(yv);
                    ssr[j] += yv * yv;
                }
            }
#pragma unroll
            for (int j = 0; j < 4; ++j) {
                float s = ssr[j];
                s += __shfl_xor(s, 1); s += __shfl_xor(s, 2); s += __shfl_xor(s, 4); s += __shfl_xor(s, 8);
                if (fr == 0) yss[(size_t)(r0 + t0 + lt * 16 + fq * 4 + j) * 64 + h * 2 + (w & 1)] = s;
            }
        }
        {
            const int pt = w >> 1; const float dec = __expf(ACS[63]);
#pragma unroll
            for (int q = 0; q < 4; ++q) {
                const int nt = (w & 1) * 4 + q;
                hacc[q] = hacc[q] * dec;
#pragma unroll
                for (int kk = 0; kk < 2; ++kk) {
                    const bf16x8 av = *(const LAS bf16x8*)(XT + (pt * 16 + fr) * SX + kk * 32 + fq * 8);
                    const bf16x8 bv = *(const LAS bf16x8*)(BWT + (nt * 16 + fr) * SX + kk * 32 + fq * 8);
                    hacc[q] = mfma16(av, bv, hacc[q]);
                }
            }
        }
        lds_barrier();
        {
            const int pt = w >> 1;
#pragma unroll
            for (int q = 0; q < 4; ++q) {
                const int n = ((w & 1) * 4 + q) * 16 + fr;
#pragma unroll
                for (int j = 0; j < 4; ++j) HB[(pt * 16 + fq * 4 + j) * SW + n] = (bf16_t)f2bf(hacc[q][j]);
            }
        }
    }
#undef SCAN_ISSUE
    {
        float* so = a.out + O_SSMP + (size_t)(b * 32 + h) * 64 * 128;
        const int pt = w >> 1;
#pragma unroll
        for (int q = 0; q < 4; ++q) {
            const int n = ((w & 1) * 4 + q) * 16 + fr;
#pragma unroll
            for (int j = 0; j < 4; ++j) so[(size_t)(pt * 16 + fq * 4 + j) * 128 + n] = hacc[q][j];
        }
    }
#undef a
}

constexpr int LS_X = 0, LS_B = LS_X + 8 * 64 * 4, LS_C = LS_B + 8 * 128 * 4, LS_DT = LS_C + 8 * 128 * 4, LS_Y = LS_DT + 64, LS_END = LS_Y + 8 * 64 * 4;
__device__ __forceinline__ void scan_sample_all(LAS unsigned char* lds, int G, int bid) {
    const KArgs ap = kargs();
    int tid_ = threadIdx.x; asm volatile("" : "+v"(tid_));
    const int tid = tid_, lane = tid & 63, w = tid >> 6;
    unsigned char* ws = ap->ws;
    const bf16_t* proj = (const bf16_t*)(ws + WS_R1);
    const float* dtraw = (const float*)(ws + WS_DT);
    bf16_t* yg = (bf16_t*)(ws + WS_YG); float* yss = (float*)(ws + WS_YSS);
    LAS float* XS = (LAS float*)(lds + LS_X); LAS float* BSs = (LAS float*)(lds + LS_B); LAS float* CSs = (LAS float*)(lds + LS_C);
    LAS float* DTs = (LAS float*)(lds + LS_DT); LAS float* YS = (LAS float*)(lds + LS_Y);
    const int p = tid >> 3, nb = (tid & 7) * 16;
    const bool conv_t = tid < 320, dt_t = (tid >= 320 && tid < 328);
    const int crel = (tid < 64) ? tid : (tid < 192) ? (tid - 64) : (tid - 192);
    LAS float* cdst = (tid < 64) ? (XS + tid) : (tid < 192) ? (BSs + (tid - 64)) : (CSs + (tid - 192));
    const int dstride = (tid < 64) ? 64 : 128;
    int it = bid; if (it >= 4096) return;
    f32x4 hn[4]; float cin[11], wn[5], dtn = 0.f, zn;
#pragma unroll
    for (int i = 0; i < 11; ++i) cin[i] = 0.f;
#pragma unroll
    for (int i = 0; i < 5; ++i) wn[i] = 0.f;
#define SAMPLE_ISSUE(it_) do { const int b_ = (it_) >> 5, h_ = (it_) & 31, g_ = h_ >> 2, r0_ = MP + b_ * 8; \
        const float* hin_ = ap->in[2] + ((size_t)(b_ * 32 + h_) * 64 + p) * 128 + nb; \
        _Pragma("unroll") for (int i_ = 0; i_ < 4; ++i_) hn[i_] = *(const f32x4*)(hin_ + 4 * i_); \
        if (conv_t) { const int col_ = (tid < 64) ? (2048 + h_ * 64 + crel) : (tid < 192) ? (4096 + g_ * 128 + crel) : (5120 + g_ * 128 + crel); const int ch_ = col_ - 2048; \
            const float* cwp_ = ap->in[11] + ch_; wn[0] = cwp_[0]; wn[1] = cwp_[4096]; wn[2] = cwp_[8192]; wn[3] = cwp_[12288]; wn[4] = ap->in[12][ch_]; \
            const float* cs_ = ap->in[3] + (size_t)b_ * 3 * 4096 + ch_; cin[0] = cs_[0]; cin[1] = cs_[4096]; cin[2] = cs_[8192]; \
            _Pragma("unroll") for (int t_ = 0; t_ < 8; ++t_) cin[3 + t_] = bf1(proj[(size_t)(r0_ + t_) * NPROJ + col_]); } \
        else if (dt_t) { dtn = dtraw[(size_t)(r0_ + tid - 320) * 32 + h_] + ap->in[13][h_]; } \
        zn = bf1(proj[(size_t)(r0_ + w) * NPROJ + h_ * 64 + lane]); } while (0)
    SAMPLE_ISSUE(it);
#pragma unroll 1
    for (; it < 4096; it += G) {
        const int b = it >> 5, h = it & 31, r0 = MP + b * 8;
        const float Ah = -__expf(ap->in[14][h]), Dh = ap->in[15][h];
        f32x4 hs[4];
#pragma unroll
        for (int i = 0; i < 4; ++i) hs[i] = hn[i];
        const float zc = zn;
        lds_barrier();
        if (conv_t) {
            float q0 = cin[0], q1 = cin[1], q2 = cin[2];
#pragma unroll
            for (int t = 0; t < 8; ++t) {
                const float cur = cin[3 + t];
                const float v = wn[4] + wn[0] * q0 + wn[1] * q1 + wn[2] * q2 + wn[3] * cur;
                cdst[t * dstride] = silu_f(v);
                q0 = q1; q1 = q2; q2 = cur;
            }
        } else if (dt_t) {
            DTs[tid - 320] = (dtn > 20.f) ? dtn : log1pf(__expf(dtn));
        }
        { const int itn = (it + G < 4096) ? (it + G) : it; SAMPLE_ISSUE(itn); }
        lds_barrier();
#pragma unroll
        for (int t = 0; t < 8; ++t) {
            const float dt = DTs[t], dec = __expf(dt * Ah), xv = XS[t * 64 + p] * dt;
            float yp = 0.f;
#pragma unroll
            for (int i = 0; i < 4; ++i) {
                const f32x4 bv = *(const LAS f32x4*)(BSs + t * 128 + nb + 4 * i);
                const f32x4 cv = *(const LAS f32x4*)(CSs + t * 128 + nb + 4 * i);
                hs[i] = hs[i] * dec + bv * xv;
                yp += (hs[i][0] * cv[0] + hs[i][1] * cv[1]) + (hs[i][2] * cv[2] + hs[i][3] * cv[3]);
            }
            yp += __shfl_xor(yp, 1); yp += __shfl_xor(yp, 2); yp += __shfl_xor(yp, 4);
            if ((tid & 7) == 0) YS[t * 64 + p] = yp;
        }
        {
            float* so = ap->out + O_SSMS + ((size_t)(b * 32 + h) * 64 + p) * 128 + nb;
#pragma unroll
            for (int i = 0; i < 4; ++i) *(f32x4*)(so + 4 * i) = hs[i];
        }
        lds_barrier();
        {
            const int t = w;
            const float y = YS[t * 64 + lane] + Dh * XS[t * 64 + lane];
            const float yv = y * silu_f(zc);
            yg[(size_t)(r0 + t) * DI + h * 64 + lane] = (bf16_t)f2bf(yv);
            const float s = wave_sum(yv * yv);
            if (lane < 2) yss[(size_t)(r0 + t) * 64 + h * 2 + lane] = (lane == 0) ? s : 0.f;
        }
    }
#undef SAMPLE_ISSUE
}

__device__ __forceinline__ void phase_scan(LAS unsigned char* lds, int G, int bid) {
    for (int it = bid; it < 256; it += G) { __syncthreads(); scan_prompt_item(lds, it >> 5, it & 31); }
    __syncthreads();
    scan_sample_all(lds, G, bid);
}

__device__ __forceinline__ void phase_ynorm(int G, int bid) {
    const KArgs ap = kargs();
#define a (*ap)
    bf16_t* yg = (bf16_t*)(a.ws + WS_YG); const float* yss = (const float*)(a.ws + WS_YSS);
    const int total = MT * 256;
    int tid_ = threadIdx.x; asm volatile("" : "+v"(tid_));
    for (int idx = bid * NTHR + tid_; idx < total; idx += G * NTHR) {
        const int r = idx >> 8, cc = idx & 255, g = cc >> 5;
        const f32x4 s0 = *(const f32x4*)(yss + (size_t)r * 64 + g * 8), s1 = *(const f32x4*)(yss + (size_t)r * 64 + g * 8 + 4);
        const float ss = ((s0[0] + s0[1]) + (s0[2] + s0[3])) + ((s1[0] + s1[1]) + (s1[2] + s1[3]));
        const float rs = rsqrtf(ss * (1.0f / 256.0f) + EPS);
        u32x4* ptr = (u32x4*)(yg + (size_t)r * DI + cc * 8);
        const u32x4 v = *ptr; float f[8]; unpack8(v, f);
        u32x4 o; o.x = cvt_pk_bf16(f[0] * rs, f[1] * rs); o.y = cvt_pk_bf16(f[2] * rs, f[3] * rs); o.z = cvt_pk_bf16(f[4] * rs, f[5] * rs); o.w = cvt_pk_bf16(f[6] * rs, f[7] * rs);
        *ptr = o;
    }
#undef a
}

__device__ __forceinline__ void phase_poolstats(int G, int bid) {
    const KArgs ap = kargs();
#define a (*ap)
    const bf16_t* ub = (const bf16_t*)(a.ws + WS_R1);
    bf16_t* mixed = (bf16_t*)(a.ws + WS_R1 + (size_t)MT * DM * 2);
    const float* spool = a.in[4];
    const int total = MT * 128;
    int tid_ = threadIdx.x; asm volatile("" : "+v"(tid_));
    for (int idx = bid * NTHR + tid_; idx < total; idx += G * NTHR) {
        const int r = idx >> 7, cc = idx & 127, c0 = cc * 8, k = cc >> 5, wlen = 2 << k;
        float sum[8] = {0.f, 0.f, 0.f, 0.f, 0.f, 0.f, 0.f, 0.f}; float own[8]; float cnt;
        {
            const u32x4 v = *(const u32x4*)(ub + (size_t)r * DM + c0); unpack8(v, own);
        }
        if (r < MP) {
            const int t = r & 2047; const int n = (t + 1 < wlen) ? (t + 1) : wlen; cnt = (float)n;
            for (int i = 0; i < n; ++i) { const u32x4 v = *(const u32x4*)(ub + (size_t)(r - i) * DM + c0); float f[8]; unpack8(v, f);
#pragma unroll
                for (int e = 0; e < 8; ++e) sum[e] += f[e]; }
        } else {
            const int q = r - MP, bb = q >> 3, t = q & 7; cnt = (float)wlen;
            for (int i = 0; i < wlen; ++i) {
                const int e_ = 15 + t - i;
                if (e_ >= 15) { const u32x4 v = *(const u32x4*)(ub + (size_t)(MP + bb * 8 + (e_ - 15)) * DM + c0); float f[8]; unpack8(v, f);
#pragma unroll
                    for (int e = 0; e < 8; ++e) sum[e] += f[e]; }
                else { const float* sp = spool + ((size_t)bb * 15 + e_) * 1024 + c0; const f32x4 v0 = *(const f32x4*)sp, v1 = *(const f32x4*)(sp + 4);
#pragma unroll
                    for (int e = 0; e < 4; ++e) { sum[e] += v0[e]; sum[4 + e] += v1[e]; } }
            }
        }
        const float inv = 1.0f / cnt;
        u32x4 o; o.x = cvt_pk_bf16(sum[0] * inv - own[0], sum[1] * inv - own[1]); o.y = cvt_pk_bf16(sum[2] * inv - own[2], sum[3] * inv - own[3]);
        o.z = cvt_pk_bf16(sum[4] * inv - own[4], sum[5] * inv - own[5]); o.w = cvt_pk_bf16(sum[6] * inv - own[6], sum[7] * inv - own[7]);
        *(u32x4*)(mixed + (size_t)r * DM + c0) = o;
    }
    float* pools = a.out + O_POOLS;
    const int tot2 = 128 * 7 * 256;
    for (int idx = bid * NTHR + tid_; idx < tot2; idx += G * NTHR) {
        const int c4 = idx & 255, j = (idx >> 8) % 7, bb = idx / (7 * 256);
        *(f32x4*)(pools + ((size_t)bb * 15 + j) * 1024 + c4 * 4) = *(const f32x4*)(spool + ((size_t)bb * 15 + 8 + j) * 1024 + c4 * 4);
    }
#undef a
}

__device__ __forceinline__ void phase_final(int G, int bid) {
    const KArgs ap = kargs();
#define a (*ap)
    const float* xres = (const float*)(a.ws + WS_XRES); const float* ssq = (const float*)(a.ws + WS_SSQ); const float* gn = a.in[22];
    float* y = a.out + O_Y;
    const int total = MT * 256;
    int tid_ = threadIdx.x; asm volatile("" : "+v"(tid_));
    for (int idx = bid * NTHR + tid_; idx < total; idx += G * NTHR) {
        const int r = idx >> 8, c4 = idx & 255;
        const float* sp = ssq + (size_t)r * 16;
        const f32x4 q0 = *(const f32x4*)sp, q1 = *(const f32x4*)(sp + 4), q2 = *(const f32x4*)(sp + 8), q3 = *(const f32x4*)(sp + 12);
        const float ss = (((q0[0] + q0[1]) + (q0[2] + q0[3])) + ((q1[0] + q1[1]) + (q1[2] + q1[3]))) + (((q2[0] + q2[1]) + (q2[2] + q2[3])) + ((q3[0] + q3[1]) + (q3[2] + q3[3])));
        const float rs = rsqrtf(ss * (1.0f / 1024.0f) + EPS);
        const f32x4 v = *(const f32x4*)(xres + (size_t)r * DM + c4 * 4), gg = *(const f32x4*)(gn + c4 * 4);
        *(f32x4*)(y + (size_t)r * DM + c4 * 4) = v * rs * gg;
    }
#undef a
}

__device__ __forceinline__ void run_ffn_up(LAS unsigned char* lds, int f, int G, int bid) {
    const KArgs ap = kargs(); unsigned char* ws = ap->ws;
    EpiSwiGLU e; e.act = (bf16_t*)(ws + WS_R1); e.ssq = (const float*)(ws + WS_SSQ);
    Order S; S.init(MT / BM, 5632 / BM, G, bid);
    gemm_phase(lds, (const bf16_t*)(ws + WS_XB), DM, 0, (const bf16_t*)(ws + WS_WGU) + (size_t)f * 5632 * 1024, DM, S, e);
}
__device__ __forceinline__ void run_resid(LAS unsigned char* lds, int which, int f, int G, int bid) {
    const KArgs ap = kargs(); unsigned char* ws = ap->ws;
    float* xres = (float*)(ws + WS_XRES);
    EpiResid e; e.rin0 = xres; e.rin1 = xres; e.rout = xres; e.xb = (bf16_t*)(ws + WS_XB); e.ssq = (float*)(ws + WS_SSQ); e.scale = (which == 0) ? 0.5f : 1.0f;
    if (which == 0 && f == 0) { e.rin0 = ap->in[0]; e.rin1 = ap->in[1] - (size_t)MP * DM; }
    const bf16_t* A; const bf16_t* Bt; int K;
    if (which == 0) { A = (const bf16_t*)(ws + WS_R1); Bt = (const bf16_t*)(ws + WS_WD) + (size_t)f * 1024 * 2816; K = FF; }
    else if (which == 1) { A = (const bf16_t*)(ws + WS_YG); Bt = (const bf16_t*)(ws + WS_WOUT); K = DI; }
    else { A = (const bf16_t*)(ws + WS_R1) + (size_t)2 * MT * DM; Bt = (const bf16_t*)(ws + WS_WPOUT); K = DM; }
    Order S; S.init(MT / BM, DM / BM, G, bid);
    gemm_phase(lds, A, K, 0, Bt, K, S, e);
}
__device__ __forceinline__ void run_proj(LAS unsigned char* lds, int G, int bid) {
    const KArgs ap = kargs(); unsigned char* ws = ap->ws;
    EpiProj e; e.proj = (bf16_t*)(ws + WS_R1); e.dtraw = (float*)(ws + WS_DT); e.ssq = (const float*)(ws + WS_SSQ); e.convp = ap->out + O_CONVP; e.convs = ap->out + O_CONVS; e.halo = (bf16_t*)(ws + WS_HALO);
    Order S; S.init(MT / BM, NINP / BM, G, bid);
    gemm_phase(lds, (const bf16_t*)(ws + WS_XB), DM, 0, (const bf16_t*)(ws + WS_WIN), DM, S, e);
}
__device__ __forceinline__ void run_poolin(LAS unsigned char* lds, int G, int bid) {
    const KArgs ap = kargs(); unsigned char* ws = ap->ws;
    EpiPoolIn e; e.ub = (bf16_t*)(ws + WS_R1); e.ssq = (const float*)(ws + WS_SSQ); e.poolp = ap->out + O_POOLP; e.pools = ap->out + O_POOLS;
    Order S; S.init(MT / BM, DM / BM, G, bid);
    gemm_phase(lds, (const bf16_t*)(ws + WS_XB), DM, 0, (const bf16_t*)(ws + WS_WPIN), DM, S, e);
}
__device__ __forceinline__ void run_poolgrp(LAS unsigned char* lds, int G, int bid) {
    const KArgs ap = kargs(); unsigned char* ws = ap->ws;
    bf16_t* ub = (bf16_t*)(ws + WS_R1);
    EpiBf16 e; e.O = ub + (size_t)2 * MT * DM; e.ldc = DM;
    Order S; S.init(MT / BM, DM / BM, G, bid);
    gemm_phase(lds, ub + (size_t)MT * DM, DM, 256, (const bf16_t*)(ws + WS_WPG), 256, S, e);
}

__global__ void __launch_bounds__(NTHR, 2) fwd_megakernel(Args a_unused) {
    extern __shared__ __attribute__((aligned(16))) unsigned char lds_raw[];
    LAS unsigned char* lds = (LAS unsigned char*)lds_raw;
    cg::grid_group grid = cg::this_grid();
    const int G = gridDim.x, bid = blockIdx.x;

    phase_prep(lds, G, bid);
    grid.sync();
#pragma unroll 1
    for (int f = 0; f < 4; ++f) {
        run_ffn_up(lds, f, G, bid);
        grid.sync();
        run_resid(lds, 0, f, G, bid);
        grid.sync();
        if (f == 0) {
            run_proj(lds, G, bid);
            grid.sync();
            phase_conv(G, bid);
            grid.sync();
            phase_scan(lds, G, bid);
            grid.sync();
            phase_ynorm(G, bid);
            grid.sync();
            run_resid(lds, 1, f, G, bid);
            grid.sync();
        }
        if (f == 2) {
            run_poolin(lds, G, bid);
            grid.sync();
            phase_poolstats(G, bid);
            grid.sync();
            run_poolgrp(lds, G, bid);
            grid.sync();
            run_resid(lds, 2, f, G, bid);
            grid.sync();
        }
    }
    phase_final(G, bid);
}

extern "C" void kernel_launch(void* const* d_in, const int* in_sizes, int n_in, void* d_out, int out_size, void* d_ws, size_t ws_size, hipStream_t stream) {
    static int grid_blocks = 0;
    if (grid_blocks == 0) {
        if (n_in != 23 || ws_size < WS_END) { fprintf(stderr, "kernel_launch: need 23 inputs and %zu B of workspace (got %d, %zu)\n", (size_t)WS_END, n_in, ws_size); grid_blocks = -1; return; }
        int dev = 0, cus = 0, per_cu = 0;
        (void)hipGetDevice(&dev);
        (void)hipDeviceGetAttribute(&cus, hipDeviceAttributeMultiprocessorCount, dev);
        if (hipFuncSetAttribute((const void*)fwd_megakernel, hipFuncAttributeMaxDynamicSharedMemorySize, LDS_BYTES) != hipSuccess) { fprintf(stderr, "kernel_launch: hipFuncSetAttribute failed\n"); }
        if (hipOccupancyMaxActiveBlocksPerMultiprocessor(&per_cu, (const void*)fwd_megakernel, NTHR, LDS_BYTES) != hipSuccess || per_cu < 1) { fprintf(stderr, "kernel_launch: occupancy query gave %d\n", per_cu); per_cu = 1; }
        (void)hipGetLastError();
        if (per_cu > 1) per_cu = 1;
        grid_blocks = cus * per_cu;
    }
    if (grid_blocks < 0) return;
    Args a{};
    for (int i = 0; i < 23; ++i) a.in[i] = (const float*)d_in[i];
    a.out = (float*)d_out; a.ws = (unsigned char*)d_ws;
    void* args[] = {&a};
    hipError_t e = hipLaunchCooperativeKernel((const void*)fwd_megakernel, dim3(grid_blocks), dim3(NTHR), args, LDS_BYTES, stream);
    if (e != hipSuccess) fprintf(stderr, "cooperative launch failed: %s (grid %d)\n", hipGetErrorString(e), grid_blocks);
}
```

```cpp
#include <hip/hip_runtime.h>
#include <hip/hip_cooperative_groups.h>
#include <cstdio>
namespace cg = cooperative_groups;

#define LAS __attribute__((address_space(3)))
typedef unsigned short bf16_t;
typedef short bf16x8 __attribute__((ext_vector_type(8)));
typedef float f32x4 __attribute__((ext_vector_type(4)));
typedef unsigned u32x4 __attribute__((ext_vector_type(4)));
typedef unsigned u32x2 __attribute__((ext_vector_type(2)));

constexpr int MP = 16384, MS = 1024, MT = MP + MS;
constexpr int DM = 1024, FF = 2816, DI = 2048, NPROJ = 6144, NINP = 6400, NIN = 6176;
constexpr float EPS = 1e-6f;
constexpr int NTHR = 512;
constexpr int LDS_BYTES = 131072;

constexpr size_t WS_WGU = 0;
constexpr size_t WS_WD = WS_WGU + (size_t)4 * 5632 * 1024 * 2;
constexpr size_t WS_WIN = WS_WD + (size_t)4 * 1024 * 2816 * 2;
constexpr size_t WS_WOUT = WS_WIN + (size_t)NINP * 1024 * 2;
constexpr size_t WS_WPIN = WS_WOUT + (size_t)1024 * 2048 * 2;
constexpr size_t WS_WPG = WS_WPIN + (size_t)1024 * 1024 * 2;
constexpr size_t WS_WPOUT = WS_WPG + (size_t)1024 * 256 * 2;
constexpr size_t WS_XRES = WS_WPOUT + (size_t)1024 * 1024 * 2;
constexpr size_t WS_XB = WS_XRES + (size_t)MT * 1024 * 4;
constexpr size_t WS_SSQ = WS_XB + (size_t)MT * 1024 * 2;
constexpr size_t WS_YSS = WS_SSQ + (size_t)MT * 16 * 4;
constexpr size_t WS_DT = WS_YSS + (size_t)MT * 64 * 4;
constexpr size_t WS_YG = WS_DT + (size_t)MT * 32 * 4;
constexpr size_t WS_R1 = WS_YG + (size_t)MT * 2048 * 2;
constexpr size_t WS_HALO = WS_R1 + (size_t)MT * NPROJ * 2;
constexpr size_t WS_END = WS_HALO + (size_t)8 * 32 * 3 * 4096 * 2;

constexpr size_t O_Y = 0;
constexpr size_t O_SSMP = (size_t)MT * 1024;
constexpr size_t O_CONVP = O_SSMP + (size_t)8 * 32 * 64 * 128;
constexpr size_t O_POOLP = O_CONVP + (size_t)8 * 3 * 4096;
constexpr size_t O_SSMS = O_POOLP + (size_t)8 * 15 * 1024;
constexpr size_t O_CONVS = O_SSMS + (size_t)128 * 32 * 64 * 128;
constexpr size_t O_POOLS = O_CONVS + (size_t)128 * 3 * 4096;

struct Args { const float* in[23]; float* out; unsigned char* ws; };
typedef const __attribute__((address_space(4))) Args* KArgs;
__device__ __forceinline__ KArgs kargs() { KArgs p = (KArgs)__builtin_amdgcn_kernarg_segment_ptr(); asm volatile("" : "+s"(p)); return p; }

__device__ __forceinline__ unsigned f2bf(float f) { unsigned u = __float_as_uint(f); u += 0x7FFFu + ((u >> 16) & 1u); return u >> 16; }
__device__ __forceinline__ unsigned pk2(float lo, float hi) { return f2bf(lo) | (f2bf(hi) << 16); }
__device__ __forceinline__ unsigned cvt_pk_bf16(float lo, float hi) { unsigned r; asm volatile("v_cvt_pk_bf16_f32 %0, %1, %2" : "=v"(r) : "v"(lo), "v"(hi)); return r; }
__device__ __forceinline__ float bflo(unsigned w) { return __uint_as_float(w << 16); }
__device__ __forceinline__ float bfhi(unsigned w) { return __uint_as_float(w & 0xffff0000u); }
__device__ __forceinline__ float bf1(bf16_t v) { return __uint_as_float(((unsigned)v) << 16); }
__device__ __forceinline__ float silu_f(float v) { return v * __builtin_amdgcn_rcpf(1.0f + __expf(-v)); }
__device__ __forceinline__ float wave_sum(float v) {
#pragma unroll
    for (int o = 1; o < 64; o <<= 1) v += __shfl_xor(v, o);
    return v;
}
#define LDS_WAIT() asm volatile("s_waitcnt lgkmcnt(0)" ::: "memory")

constexpr int BM = 256, BK = 64, HALF = 128, HTB = HALF * BK * 2, NXCD = 8, WGM = 8;
__device__ __forceinline__ int lds_byte(int r, int c) { const int st = (r >> 4) * 2 + (c >> 5), rr = r & 15, cc = c & 31, ob = rr * 64 + cc * 2; return st * 1024 + (ob ^ (((ob >> 9) & 1) << 5)); }
__device__ __forceinline__ void stage_rc(int b, int& R, int& C) { const int st = b / 1024, sb = b % 1024, swz = sb ^ (((sb >> 9) & 1) << 5); R = (st >> 1) * 16 + swz / 64; C = (st & 1) * 32 + (swz % 64) / 2; }
__device__ __forceinline__ int perm32(int rho) { const int n = rho >> 4, i = rho & 15; return 8 * (i >> 2) + 4 * n + (i & 3); }

struct Unit { int pm, pn; };
struct Order {
    int nM, nN, nwg, G, c;
    __device__ __forceinline__ void init(int nM_, int nN_, int G_, int c_) { nM = nM_; nN = nN_; nwg = nM * nN; G = G_; c = c_; }
    __device__ __forceinline__ bool next(int i, Unit& u) const {
        const long L = (long)i * G + c; if (L >= nwg) return false;
        int wgid = (int)L; { const int q = nwg / NXCD, r = nwg % NXCD, xcd = wgid % NXCD, off = wgid / NXCD; wgid = (xcd < r ? xcd * (q + 1) : r * (q + 1) + (xcd - r) * q) + off; }
        const int nig = WGM * nN, gid = wgid / nig, fm = gid * WGM, gsz = (nM - fm) < WGM ? (nM - fm) : WGM;
        u.pm = fm + ((wgid % nig) % gsz); u.pn = (wgid % nig) / gsz; return true;
    }
};

template <class Epi>
__device__ __forceinline__ void gemm_phase(LAS unsigned char* lds, const bf16_t* A, int lda, int a_pn_off, const bf16_t* Bt, int K, const Order& S, const Epi& E) {
    int tid_ = threadIdx.x; asm volatile("" : "+v"(tid_));
    const int tid = tid_, wid = __builtin_amdgcn_readfirstlane(tid >> 6), lane = tid & 63, wr = wid >> 2, wc = wid & 3, fr = lane & 15, fq = lane >> 4;
    const int nt = K / BK;
    unsigned voffA[2], voffB[2];
#pragma unroll
    for (int i = 0; i < 2; ++i) { int R, C; stage_rc(tid * 16 + i * 8192, R, C); const int Rb = Epi::PERM ? ((R & ~31) + perm32(R & 31)) : R;
        voffA[i] = (unsigned)(R * lda + C) * 2u; voffB[i] = (unsigned)(Rb * K + C) * 2u; }
    const size_t kstep = (size_t)(BK * 2);
    const size_t hstepA = (size_t)HALF * lda * 2, hstepB = (size_t)HALF * K * 2;
    const size_t tstepA = 2 * hstepA, tstepB = 2 * hstepB;
    const unsigned ldsw = (unsigned)wid * 1024u;
    const int aoff = lds_byte(wr * 64 + fr, fq * 8), boff = lds_byte(wc * 32 + fr, fq * 8);
#define PG8_SA(b, h) (((b) * 2 + (h)) * HTB)
#define PG8_SB(b, h) ((4 + (b) * 2 + (h)) * HTB)
#define PG8_STAGE(bufoff, gbase, voff) do { _Pragma("unroll") for (int _i = 0; _i < 2; ++_i) \
        __builtin_amdgcn_global_load_lds((const unsigned*)((const char*)(gbase) + (voff)[_i]), (LAS unsigned*)(lds + (bufoff) + ldsw + _i * 8192), 16, 0, 0); } while (0)
#define PG8_LDA(dst, b, h) do { _Pragma("unroll") for (int m = 0; m < 4; ++m) _Pragma("unroll") for (int k = 0; k < 2; ++k) dst[m][k] = *(const LAS bf16x8*)(lds + PG8_SA(b, h) + aoff + m * 2048 + k * 1024); } while (0)
#define PG8_LDB(dst, b, h) do { _Pragma("unroll") for (int n = 0; n < 2; ++n) _Pragma("unroll") for (int k = 0; k < 2; ++k) dst[n][k] = *(const LAS bf16x8*)(lds + PG8_SB(b, h) + boff + n * 2048 + k * 1024); } while (0)
#define PG8_MMA(ai, bj, At, Bt_) do { __builtin_amdgcn_s_setprio(1); _Pragma("unroll") for (int m = 0; m < 4; ++m) _Pragma("unroll") for (int n = 0; n < 2; ++n) _Pragma("unroll") for (int k = 0; k < 2; ++k) \
        acc[ai][bj][m][n] = __builtin_amdgcn_mfma_f32_16x16x32_bf16(Bt_[n][k], At[m][k], acc[ai][bj][m][n], 0, 0, 0); __builtin_amdgcn_s_setprio(0); } while (0)
#define PG8_WAIT_V(n) asm volatile("s_waitcnt vmcnt(" #n ")" ::: "memory")
#define PG8_WAIT_L(n) asm volatile("s_waitcnt lgkmcnt(" #n ")" ::: "memory")
#define PG8_BAR __builtin_amdgcn_s_barrier()
#define PG8_SCHED __builtin_amdgcn_sched_barrier(0)
    Unit cur, nxt; int ui = 0;
    if (!S.next(0, cur)) return;
    f32x4 acc[2][2][4][2];
#pragma unroll
    for (int a = 0; a < 2; ++a)
#pragma unroll
        for (int b = 0; b < 2; ++b)
#pragma unroll
            for (int m = 0; m < 4; ++m)
#pragma unroll
                for (int n = 0; n < 2; ++n) acc[a][b][m][n] = (f32x4){0.f, 0.f, 0.f, 0.f};
    bf16x8 At[4][2], B0[2][2], B1[2][2];
    const char* cA = (const char*)A + (size_t)cur.pm * tstepA + (size_t)cur.pn * a_pn_off * 2; const char* cB = (const char*)Bt + (size_t)cur.pn * tstepB;
    PG8_STAGE(PG8_SB(0, 0), cB, voffB); PG8_STAGE(PG8_SA(0, 0), cA, voffA); PG8_STAGE(PG8_SB(0, 1), cB + hstepB, voffB); PG8_STAGE(PG8_SA(0, 1), cA + hstepA, voffA);
    if (wr == 1) PG8_BAR;
    PG8_WAIT_V(4); PG8_BAR;
    PG8_STAGE(PG8_SB(1, 0), cB + kstep, voffB); PG8_STAGE(PG8_SA(1, 0), cA + kstep, voffA); PG8_STAGE(PG8_SB(1, 1), cB + hstepB + kstep, voffB);
    PG8_WAIT_V(6); PG8_BAR;
    for (;;) {
        const bool has_next = S.next(ui + 1, nxt);
        const char* nA = has_next ? (const char*)A + (size_t)nxt.pm * tstepA + (size_t)nxt.pn * a_pn_off * 2 : cA; const char* nB = has_next ? (const char*)Bt + (size_t)nxt.pn * tstepB : cB;
        for (int t = 0; t < nt; t += 2) {
            const bool last = (t == nt - 2);
            const char* a1 = cA + (size_t)(t + 1) * kstep;
            const char* a2 = last ? nA : cA + (size_t)(t + 2) * kstep; const char* b2 = last ? nB : cB + (size_t)(t + 2) * kstep;
            const char* a3 = a2 + kstep; const char* b3 = b2 + kstep;
            PG8_LDB(B0, 0, 0); PG8_SCHED; PG8_LDA(At, 0, 0); PG8_STAGE(PG8_SA(1, 1), a1 + hstepA, voffA);
            PG8_WAIT_L(8); PG8_BAR; PG8_WAIT_L(0); PG8_MMA(0, 0, At, B0); PG8_BAR; PG8_SCHED;
            PG8_LDB(B1, 0, 1); PG8_STAGE(PG8_SB(0, 0), b2, voffB);
            PG8_BAR; PG8_WAIT_L(0); PG8_MMA(0, 1, At, B1); PG8_BAR;
            PG8_LDA(At, 0, 1); PG8_STAGE(PG8_SA(0, 0), a2, voffA);
            PG8_BAR; PG8_WAIT_L(0); PG8_MMA(1, 0, At, B0); PG8_BAR; PG8_SCHED;
            PG8_STAGE(PG8_SB(0, 1), b2 + hstepB, voffB);
            PG8_WAIT_V(6); PG8_BAR; PG8_MMA(1, 1, At, B1); PG8_BAR;
            PG8_LDB(B0, 1, 0); PG8_SCHED; PG8_LDA(At, 1, 0); PG8_STAGE(PG8_SA(0, 1), a2 + hstepA, voffA);
            PG8_WAIT_L(8); PG8_BAR; PG8_WAIT_L(0); PG8_MMA(0, 0, At, B0); PG8_BAR; PG8_SCHED;
            PG8_LDB(B1, 1, 1); PG8_STAGE(PG8_SB(1, 0), b3, voffB);
            PG8_BAR; PG8_WAIT_L(0); PG8_MMA(0, 1, At, B1); PG8_BAR;
            PG8_LDA(At, 1, 1); PG8_STAGE(PG8_SA(1, 0), a3, voffA);
            PG8_BAR; PG8_WAIT_L(0); PG8_MMA(1, 0, At, B0); PG8_BAR; PG8_SCHED;
            PG8_STAGE(PG8_SB(1, 1), b3 + hstepB, voffB);
            PG8_WAIT_V(6); PG8_BAR; PG8_MMA(1, 1, At, B1); PG8_BAR;
        }
        E(acc, cur, wr, wc, fr, fq);
        if (!has_next) break;
#pragma unroll
        for (int a = 0; a < 2; ++a)
#pragma unroll
            for (int b = 0; b < 2; ++b)
#pragma unroll
                for (int m = 0; m < 4; ++m)
#pragma unroll
                    for (int n = 0; n < 2; ++n) acc[a][b][m][n] = (f32x4){0.f, 0.f, 0.f, 0.f};
        cur = nxt; cA = nA; cB = nB; ++ui;
    }
    PG8_WAIT_V(0);
    if (wr == 0) PG8_BAR;
    PG8_BAR;
#undef PG8_SA
#undef PG8_SB
#undef PG8_STAGE
#undef PG8_LDA
#undef PG8_LDB
#undef PG8_MMA
#undef PG8_WAIT_V
#undef PG8_WAIT_L
#undef PG8_BAR
#undef PG8_SCHED
}

__device__ __forceinline__ float row_rstd(const float* ssq, int r, int fq) {
    const f32x4 q = *(const f32x4*)(ssq + (size_t)r * 16 + fq * 4);
    float s = (q[0] + q[1]) + (q[2] + q[3]);
    s += __shfl_xor(s, 16); s += __shfl_xor(s, 32);
    return rsqrtf(s * (1.0f / 1024.0f) + EPS);
}

__device__ __forceinline__ void row_rstd8(const float* ssq, int row0, int fq, float (&rs)[8]) {
    f32x4 q[8];
#pragma unroll
    for (int i = 0; i < 8; ++i) q[i] = *(const f32x4*)(ssq + (size_t)(row0 + (i >> 2) * HALF + (i & 3) * 16) * 16 + fq * 4);
#pragma unroll
    for (int i = 0; i < 8; ++i) { float s = (q[i][0] + q[i][1]) + (q[i][2] + q[i][3]); s += __shfl_xor(s, 16); s += __shfl_xor(s, 32); rs[i] = rsqrtf(s * (1.0f / 1024.0f) + EPS); }
}

struct EpiSwiGLU {
    static constexpr bool PERM = true;
    bf16_t* act; const float* ssq;
    __device__ __forceinline__ void operator()(const f32x4 (&acc)[2][2][4][2], const Unit& u, int wr, int wc, int fr, int fq) const {
        const int row0 = u.pm * BM + wr * 64 + fr, col0 = u.pn * 128 + wc * 32 + 8 * fq;
        float rs8[8]; row_rstd8(ssq, row0, fq, rs8);
#pragma unroll
        for (int ai = 0; ai < 2; ++ai)
#pragma unroll
            for (int m = 0; m < 4; ++m) {
                const int r = row0 + ai * HALF + m * 16;
                const float rs = rs8[ai * 4 + m];
                float o[8];
#pragma unroll
                for (int n = 0; n < 2; ++n)
#pragma unroll
                    for (int j = 0; j < 4; ++j) { const float g = acc[ai][0][m][n][j] * rs, uu = acc[ai][1][m][n][j] * rs; o[n * 4 + j] = silu_f(g) * uu; }
                u32x4 w; w.x = cvt_pk_bf16(o[0], o[1]); w.y = cvt_pk_bf16(o[2], o[3]); w.z = cvt_pk_bf16(o[4], o[5]); w.w = cvt_pk_bf16(o[6], o[7]);
                *(u32x4*)(act + (size_t)r * FF + col0) = w;
            }
    }
};

struct EpiResid {
    static constexpr bool PERM = false;
    const float* rin0; const float* rin1; float* rout; bf16_t* xb; float* ssq; float scale;
    __device__ __forceinline__ void operator()(const f32x4 (&acc)[2][2][4][2], const Unit& u, int wr, int wc, int fr, int fq) const {
        const float* rin = (u.pm < 64) ? rin0 : rin1;
        const int row0 = u.pm * BM + wr * 64 + fr, col0 = u.pn * BM + wc * 32 + 4 * fq;
#pragma unroll
        for (int ai = 0; ai < 2; ++ai) {
            f32x4 rb[4][2][2];
#pragma unroll
            for (int m = 0; m < 4; ++m)
#pragma unroll
                for (int bj = 0; bj < 2; ++bj)
#pragma unroll
                    for (int n = 0; n < 2; ++n) rb[m][bj][n] = *(const f32x4*)(rin + (size_t)(row0 + ai * HALF + m * 16) * DM + col0 + bj * HALF + n * 16);
#pragma unroll
            for (int m = 0; m < 4; ++m) {
                const int r = row0 + ai * HALF + m * 16; const size_t off = (size_t)r * DM + col0; float ss = 0.f;
#pragma unroll
                for (int bj = 0; bj < 2; ++bj)
#pragma unroll
                    for (int n = 0; n < 2; ++n) {
                        const size_t c = off + bj * HALF + n * 16;
                        const f32x4 b = rb[m][bj][n];
                        const f32x4 o = b + acc[ai][bj][m][n] * scale;
                        *(f32x4*)(rout + c) = o;
                        u32x2 w; w.x = cvt_pk_bf16(o[0], o[1]); w.y = cvt_pk_bf16(o[2], o[3]);
                        *(u32x2*)(xb + c) = w;
                        ss += (o[0] * o[0] + o[1] * o[1]) + (o[2] * o[2] + o[3] * o[3]);
                    }
                ss += __shfl_xor(ss, 16); ss += __shfl_xor(ss, 32);
                if (fq == 0) ssq[(size_t)r * 16 + u.pn * 4 + wc] = ss;
            }
        }
    }
};

struct EpiProj {
    static constexpr bool PERM = true;
    bf16_t* proj; float* dtraw; const float* ssq; float* convp; float* convs; bf16_t* halo;
    __device__ __forceinline__ void operator()(const f32x4 (&acc)[2][2][4][2], const Unit& u, int wr, int wc, int fr, int fq) const {
        const int row0 = u.pm * BM + wr * 64 + fr, cb = u.pn * BM + wc * 32 + 8 * fq;
        float rs8[8]; row_rstd8(ssq, row0, fq, rs8);
#pragma unroll
        for (int ai = 0; ai < 2; ++ai)
#pragma unroll
            for (int m = 0; m < 4; ++m) {
                const int r = row0 + ai * HALF + m * 16;
                const float rs = rs8[ai * 4 + m];
                float* cdst = nullptr; bf16_t* hdst = nullptr;
                if (r < MP) { const int t = r & 2047; if (t >= 2045) cdst = convp + ((size_t)(r >> 11) * 3 + (t - 2045)) * 4096;
                    else if ((t & 63) >= 61) hdst = halo + (((size_t)(r >> 11) * 32 + (t >> 6) + 1) * 3 + ((t & 63) - 61)) * 4096; }
                else { const int q = r - MP, t = q & 7; if (t >= 5) cdst = convs + ((size_t)(q >> 3) * 3 + (t - 5)) * 4096; }
#pragma unroll
                for (int bj = 0; bj < 2; ++bj) {
                    const int c0 = cb + bj * HALF;
                    const f32x4 v0 = acc[ai][bj][m][0] * rs, v1 = acc[ai][bj][m][1] * rs;
                    if (c0 < NPROJ) {
                        u32x4 w; w.x = cvt_pk_bf16(v0[0], v0[1]); w.y = cvt_pk_bf16(v0[2], v0[3]); w.z = cvt_pk_bf16(v1[0], v1[1]); w.w = cvt_pk_bf16(v1[2], v1[3]);
                        *(u32x4*)(proj + (size_t)r * NPROJ + c0) = w;
                        if (c0 >= 2048 && cdst) { *(f32x4*)(cdst + (c0 - 2048)) = v0; *(f32x4*)(cdst + (c0 - 2048) + 4) = v1; }
                        if (c0 >= 2048 && hdst) *(u32x4*)(hdst + (c0 - 2048)) = w;
                    } else if (c0 < NIN) {
                        float* d = dtraw + (size_t)r * 32 + (c0 - NPROJ);
                        *(f32x4*)d = v0; *(f32x4*)(d + 4) = v1;
                    }
                }
            }
    }
};

struct EpiPoolIn {
    static constexpr bool PERM = true;
    bf16_t* ub; const float* ssq; float* poolp; float* pools;
    __device__ __forceinline__ void operator()(const f32x4 (&acc)[2][2][4][2], const Unit& u, int wr, int wc, int fr, int fq) const {
        const int row0 = u.pm * BM + wr * 64 + fr, cb = u.pn * BM + wc * 32 + 8 * fq;
        float rs8[8]; row_rstd8(ssq, row0, fq, rs8);
#pragma unroll
        for (int ai = 0; ai < 2; ++ai)
#pragma unroll
            for (int m = 0; m < 4; ++m) {
                const int r = row0 + ai * HALF + m * 16;
                const float rs = rs8[ai * 4 + m];
                float* pdst = nullptr;
                if (r < MP) { const int t = r & 2047; if (t >= 2033) pdst = poolp + ((size_t)(r >> 11) * 15 + (t - 2033)) * 1024; }
                else { const int q = r - MP, t = q & 7; pdst = pools + ((size_t)(q >> 3) * 15 + 7 + t) * 1024; }
#pragma unroll
                for (int bj = 0; bj < 2; ++bj) {
                    const int c0 = cb + bj * HALF;
                    const f32x4 v0 = acc[ai][bj][m][0] * rs, v1 = acc[ai][bj][m][1] * rs;
                    u32x4 w; w.x = cvt_pk_bf16(v0[0], v0[1]); w.y = cvt_pk_bf16(v0[2], v0[3]); w.z = cvt_pk_bf16(v1[0], v1[1]); w.w = cvt_pk_bf16(v1[2], v1[3]);
                    *(u32x4*)(ub + (size_t)r * DM + c0) = w;
                    if (pdst) { *(f32x4*)(pdst + c0) = v0; *(f32x4*)(pdst + c0 + 4) = v1; }
                }
            }
    }
};

struct EpiBf16 {
    static constexpr bool PERM = true;
    bf16_t* O; int ldc;
    __device__ __forceinline__ void operator()(const f32x4 (&acc)[2][2][4][2], const Unit& u, int wr, int wc, int fr, int fq) const {
        const int row0 = u.pm * BM + wr * 64 + fr, cb = u.pn * BM + wc * 32 + 8 * fq;
#pragma unroll
        for (int ai = 0; ai < 2; ++ai)
#pragma unroll
            for (int m = 0; m < 4; ++m) {
                const int r = row0 + ai * HALF + m * 16;
#pragma unroll
                for (int bj = 0; bj < 2; ++bj) {
                    const f32x4 v0 = acc[ai][bj][m][0], v1 = acc[ai][bj][m][1];
                    u32x4 w; w.x = cvt_pk_bf16(v0[0], v0[1]); w.y = cvt_pk_bf16(v0[2], v0[3]); w.z = cvt_pk_bf16(v1[0], v1[1]); w.w = cvt_pk_bf16(v1[2], v1[3]);
                    *(u32x4*)(O + (size_t)r * ldc + cb + bj * HALF) = w;
                }
            }
    }
};

__device__ __forceinline__ void transpose_item(const float* W, int ldw, int nvalid, const float* kscale, bf16_t* WT, int K, int k0, int n0, int drow0, LAS unsigned short* scr, int lane) {
    float v[64];
    const bool ok = lane < nvalid;
    const float* src = W + (size_t)k0 * ldw + n0 + (ok ? lane : 0);
#pragma unroll
    for (int kk = 0; kk < 64; ++kk) v[kk] = src[(size_t)kk * ldw];
    if (kscale) {
#pragma unroll
        for (int kk = 0; kk < 64; ++kk) v[kk] *= kscale[k0 + kk];
    }
    LAS unsigned* wrow = (LAS unsigned*)(scr + lane * 66);
#pragma unroll
    for (int kk = 0; kk < 32; ++kk) wrow[kk] = ok ? cvt_pk_bf16(v[2 * kk], v[2 * kk + 1]) : 0u;
    LDS_WAIT(); asm volatile("" ::: "memory");
    const int c = lane & 7;
#pragma unroll
    for (int it = 0; it < 8; ++it) { const int n = it * 8 + (lane >> 3); const LAS unsigned* p = (const LAS unsigned*)(scr + n * 66) + c * 4;
        u32x4 o; o.x = p[0]; o.y = p[1]; o.z = p[2]; o.w = p[3];
        *(u32x4*)(WT + (size_t)(drow0 + n) * K + k0 + 8 * c) = o; }
    LDS_WAIT(); asm volatile("" ::: "memory");
}

__device__ __forceinline__ void phase_prep(LAS unsigned char* lds, int G, int bid) {
    const KArgs ap = kargs();
#define a (*ap)
    int tid_ = threadIdx.x; asm volatile("" : "+v"(tid_));
    const int tid = tid_, lane = tid & 63, wave = tid >> 6;
    LAS unsigned short* scr = (LAS unsigned short*)(lds + wave * 8448);
    const int gw = bid * 8 + wave, NGW = G * 8;
    unsigned char* ws = a.ws;
    constexpr int I_FF = 704, N_FF = 12 * I_FF, I_IN = 16 * 97, I_OUT = 32 * 16, I_PIN = 256, I_PG = 64, I_POUT = 256;
    constexpr int NITEMS = N_FF + I_IN + I_OUT + I_PIN + I_PG + I_POUT;
#pragma unroll 1
    for (int it = gw; it < NITEMS; it += NGW) {
        int r = it;
        const float* W; int ldw, nvalid = 64, K, k0, n0, drow0; const float* ksc; bf16_t* WT;
        if (r < N_FF) {
            const int mat = r / I_FF, rr = r % I_FF, type = mat >> 2, f = mat & 3;
            if (type < 2) {
                const int kb = rr / 44, nb = rr % 44; n0 = nb * 64; k0 = kb * 64;
                W = (type == 0 ? a.in[6] : a.in[7]) + (size_t)f * 1024 * 2816; ldw = 2816; ksc = a.in[5] + f * 1024;
                WT = (bf16_t*)(ws + WS_WGU) + (size_t)f * 5632 * 1024; K = 1024; drow0 = (n0 >> 7) * 256 + (n0 & 127) + type * 128;
            } else {
                const int kb = rr / 16, nb = rr % 16; n0 = nb * 64; k0 = kb * 64;
                W = a.in[8] + (size_t)f * 2816 * 1024; ldw = 1024; ksc = nullptr; WT = (bf16_t*)(ws + WS_WD) + (size_t)f * 1024 * 2816; K = 2816; drow0 = n0;
            }
        } else if ((r -= N_FF) < I_IN) { const int kb = r / 97, nb = r % 97; n0 = nb * 64; k0 = kb * 64; W = a.in[10]; ldw = NIN; ksc = a.in[9]; WT = (bf16_t*)(ws + WS_WIN); K = 1024; drow0 = n0; nvalid = (nb == 96) ? 32 : 64; }
        else if ((r -= I_IN) < I_OUT) { const int kb = r / 16, nb = r % 16; n0 = nb * 64; k0 = kb * 64; W = a.in[17]; ldw = 1024; ksc = a.in[16]; WT = (bf16_t*)(ws + WS_WOUT); K = 2048; drow0 = n0; }
        else if ((r -= I_OUT) < I_PIN) { const int kb = r / 16, nb = r % 16; n0 = nb * 64; k0 = kb * 64; W = a.in[18]; ldw = 1024; ksc = a.in[9] + 1024; WT = (bf16_t*)(ws + WS_WPIN); K = 1024; drow0 = n0; }
        else if ((r -= I_PIN) < I_PG) { const int g = r >> 4, rr = r & 15, kb = rr >> 2, nb = rr & 3; n0 = nb * 64; k0 = kb * 64; W = a.in[19] + (size_t)g * 65536; ldw = 256; ksc = nullptr; WT = (bf16_t*)(ws + WS_WPG); K = 256; drow0 = g * 256 + n0; }
        else { r -= I_PG; const int kb = r / 16, nb = r % 16; n0 = nb * 64; k0 = kb * 64; W = a.in[21]; ldw = 1024; ksc = a.in[20]; WT = (bf16_t*)(ws + WS_WPOUT); K = 1024; drow0 = n0; }
        transpose_item(W, ldw, nvalid, ksc, WT, K, k0, n0, drow0, scr, lane);
    }
    {
        u32x4* z = (u32x4*)((bf16_t*)(ws + WS_WIN) + (size_t)NIN * 1024);
        const int nz = (NINP - NIN) * 1024 / 8;
        for (int i = bid * NTHR + tid; i < nz; i += G * NTHR) z[i] = (u32x4){0u, 0u, 0u, 0u};
    }
    bf16_t* xb = (bf16_t*)(ws + WS_XB); float* ssq = (float*)(ws + WS_SSQ);
    for (int row = gw; row < MT; row += NGW) {
        const float* xr = (row < MP) ? a.in[0] + (size_t)row * DM : a.in[1] + (size_t)(row - MP) * DM;
        float s = 0.f;
#pragma unroll
        for (int j = 0; j < 4; ++j) {
            const f32x4 v = *(const f32x4*)(xr + 4 * lane + 256 * j);
            s += (v[0] * v[0] + v[1] * v[1]) + (v[2] * v[2] + v[3] * v[3]);
            u32x2 w; w.x = cvt_pk_bf16(v[0], v[1]); w.y = cvt_pk_bf16(v[2], v[3]);
            *(u32x2*)(xb + (size_t)row * DM + 4 * lane + 256 * j) = w;
        }
        s = wave_sum(s);
        if (lane < 16) ssq[(size_t)row * 16 + lane] = (lane == 0) ? s : 0.f;
    }
#undef a
}

constexpr int SX = 72, SW = 136;
constexpr int L_XT = 0;
constexpr int L_BS = L_XT + 64 * SX * 2;
constexpr int L_CS = L_BS + 64 * SW * 2;
constexpr int L_BWT = L_CS + 64 * SW * 2;
constexpr int L_LS = L_BWT + 128 * SX * 2;
constexpr int L_HB = L_LS + 64 * SX * 2;
constexpr int L_ZS = L_HB + 64 * SW * 2;
constexpr int L_DT = L_ZS + 64 * SX * 2;
constexpr int L_AC = L_DT + 256;
constexpr int L_SCAN_END = L_AC + 256;
static_assert(L_SCAN_END <= LDS_BYTES, "scan LDS");

__device__ __forceinline__ f32x4 mfma16(bf16x8 a, bf16x8 b, f32x4 c) { return __builtin_amdgcn_mfma_f32_16x16x32_bf16(a, b, c, 0, 0, 0); }

__device__ __forceinline__ void unpack8(const u32x4 w, float (&o)[8]) {
    o[0] = bflo(w.x); o[1] = bfhi(w.x); o[2] = bflo(w.y); o[3] = bfhi(w.y); o[4] = bflo(w.z); o[5] = bfhi(w.z); o[6] = bflo(w.w); o[7] = bfhi(w.w);
}

__device__ __forceinline__ void lds_barrier() { asm volatile("s_waitcnt lgkmcnt(0)" ::: "memory"); __builtin_amdgcn_s_barrier(); asm volatile("" ::: "memory"); }

__device__ __forceinline__ void phase_conv(int G, int bid) {
    const KArgs ap = kargs();
    int tid_ = threadIdx.x; asm volatile("" : "+v"(tid_));
    const int tid = tid_, cgl = tid & 127, seg = tid >> 7;
    unsigned char* ws = ap->ws;
    bf16_t* proj = (bf16_t*)(ws + WS_R1); const bf16_t* halo = (const bf16_t*)(ws + WS_HALO);
    const float* cwg = ap->in[11]; const float* cbg = ap->in[12];
#pragma unroll 1
    for (int item = bid; item < 1024; item += G) {
        const int tile = item >> 2, slab = item & 3, b = tile >> 5, ti = tile & 31;
        const int ch0 = slab * 1024 + cgl * 8;
        const size_t rowt = (size_t)b * 2048 + ti * 64;
        float cw[4][8], cbias[8];
#pragma unroll
        for (int k = 0; k < 4; ++k) { const f32x4 w0 = *(const f32x4*)(cwg + k * 4096 + ch0), w1 = *(const f32x4*)(cwg + k * 4096 + ch0 + 4);
#pragma unroll
            for (int e = 0; e < 4; ++e) { cw[k][e] = w0[e]; cw[k][4 + e] = w1[e]; } }
        { const f32x4 b0 = *(const f32x4*)(cbg + ch0), b1 = *(const f32x4*)(cbg + ch0 + 4);
#pragma unroll
            for (int e = 0; e < 4; ++e) { cbias[e] = b0[e]; cbias[4 + e] = b1[e]; } }
        u32x4 rows[19];
#pragma unroll
        for (int i = 0; i < 19; ++i) {
            const int trel = seg * 16 - 3 + i;
            if (trel >= 0) rows[i] = *(const u32x4*)(proj + (rowt + trel) * NPROJ + 2048 + ch0);
            else if (ti > 0) rows[i] = *(const u32x4*)(halo + (((size_t)b * 32 + ti) * 3 + (trel + 3)) * 4096 + ch0);
            else rows[i] = (u32x4){0u, 0u, 0u, 0u};
        }
        __syncthreads();
        float p0[8], p1[8], p2[8];
        unpack8(rows[0], p0); unpack8(rows[1], p1); unpack8(rows[2], p2);
#pragma unroll
        for (int e = 0; e < 16; ++e) {
            float cur[8]; unpack8(rows[3 + e], cur);
            float y[8];
#pragma unroll
            for (int k = 0; k < 8; ++k) { const float v = cbias[k] + cw[0][k] * p0[k] + cw[1][k] * p1[k] + cw[2][k] * p2[k] + cw[3][k] * cur[k]; y[k] = silu_f(v); }
            u32x4 pk; pk.x = cvt_pk_bf16(y[0], y[1]); pk.y = cvt_pk_bf16(y[2], y[3]); pk.z = cvt_pk_bf16(y[4], y[5]); pk.w = cvt_pk_bf16(y[6], y[7]);
            *(u32x4*)(proj + (rowt + seg * 16 + e) * NPROJ + 2048 + ch0) = pk;
#pragma unroll
            for (int k = 0; k < 8; ++k) { p0[k] = p1[k]; p1[k] = p2[k]; p2[k] = cur[k]; }
        }
    }
}

__device__ __forceinline__ void scan_prompt_item(LAS unsigned char* lds, int b, int h) {
    const KArgs ap = kargs();
#define a (*ap)
    int tid_ = threadIdx.x; asm volatile("" : "+v"(tid_));
    const int tid = tid_, lane = tid & 63, w = __builtin_amdgcn_readfirstlane(tid >> 6), fr = lane & 15, fq = lane >> 4;
    const int g = h >> 2;
    unsigned char* ws = a.ws;
    const bf16_t* proj = (const bf16_t*)(ws + WS_R1);
    const float* dtraw = (const float*)(ws + WS_DT);
    bf16_t* yg = (bf16_t*)(ws + WS_YG); float* yss = (float*)(ws + WS_YSS);
    const int r0 = b * 2048;
    const float dtb = a.in[13][h], Ah = -__expf(a.in[14][h]), Dh = a.in[15][h];
    LAS bf16_t* XT = (LAS bf16_t*)(lds + L_XT); LAS bf16_t* BS = (LAS bf16_t*)(lds + L_BS); LAS bf16_t* CS = (LAS bf16_t*)(lds + L_CS);
    LAS bf16_t* BWT = (LAS bf16_t*)(lds + L_BWT); LAS bf16_t* LS = (LAS bf16_t*)(lds + L_LS); LAS bf16_t* HB = (LAS bf16_t*)(lds + L_HB);
    LAS bf16_t* ZS = (LAS bf16_t*)(lds + L_ZS); LAS float* DTS = (LAS float*)(lds + L_DT); LAS float* ACS = (LAS float*)(lds + L_AC);
    const int sx = tid >> 3, qx = tid & 7, sb = tid >> 4, qb = tid & 15;
    const bf16_t* px = proj + (size_t)(r0 + sx) * NPROJ + 2048 + h * 64 + qx * 8;
    const bf16_t* pz = proj + (size_t)(r0 + sx) * NPROJ + h * 64 + qx * 8;
    const bf16_t* pb = proj + (size_t)(r0 + sb) * NPROJ + 4096 + g * 128 + qb * 8;
    const float* pd = dtraw + (size_t)(r0 + lane) * 32 + h;
    u32x4 rx, rz, rb0, rb1, rc0, rc1; float rdt;
#define SCAN_ISSUE(c_) do { const size_t o_ = (size_t)(c_) * 64 * NPROJ; \
        rx = *(const u32x4*)(px + o_); rz = *(const u32x4*)(pz + o_); \
        rb0 = *(const u32x4*)(pb + o_); rb1 = *(const u32x4*)(pb + o_ + (size_t)32 * NPROJ); \
        rc0 = *(const u32x4*)(pb + o_ + 1024); rc1 = *(const u32x4*)(pb + o_ + (size_t)32 * NPROJ + 1024); \
        rdt = pd[(size_t)(c_) * 64 * 32]; } while (0)
    SCAN_ISSUE(0);
    for (int i = tid; i < 64 * SW / 2; i += NTHR) ((LAS unsigned*)HB)[i] = 0u;
    f32x4 hacc[4];
#pragma unroll
    for (int q = 0; q < 4; ++q) hacc[q] = (f32x4){0.f, 0.f, 0.f, 0.f};

#pragma unroll 1
    for (int c = 0; c < 32; ++c) {
        const int t0 = c * 64;
        {
            const float v = rdt + dtb;
            const float dtl = (v > 20.f) ? v : log1pf(__expf(v));
            float s = dtl * Ah;
#pragma unroll
            for (int o = 1; o < 64; o <<= 1) { const float n = __shfl_up(s, o); if (lane >= o) s += n; }
            const float tot = __shfl(s, 63);
            const float wgt = dtl * __expf(tot - s);
            if (w == 0) { DTS[lane] = dtl; ACS[lane] = s; }
            const float wb0 = __shfl(wgt, sb), wb1 = __shfl(wgt, sb + 32);
            {
                const unsigned xw[4] = {rx.x, rx.y, rx.z, rx.w};
#pragma unroll
                for (int k = 0; k < 4; ++k) { XT[(qx * 8 + 2 * k) * SX + sx] = (bf16_t)(xw[k] & 0xffffu); XT[(qx * 8 + 2 * k + 1) * SX + sx] = (bf16_t)(xw[k] >> 16); }
            }
            *(LAS u32x4*)(ZS + sx * SX + qx * 8) = rz;
            *(LAS u32x4*)(BS + sb * SW + qb * 8) = rb0; *(LAS u32x4*)(BS + (sb + 32) * SW + qb * 8) = rb1;
            *(LAS u32x4*)(CS + sb * SW + qb * 8) = rc0; *(LAS u32x4*)(CS + (sb + 32) * SW + qb * 8) = rc1;
            {
                float f0[8], f1[8]; unpack8(rb0, f0); unpack8(rb1, f1);
#pragma unroll
                for (int k = 0; k < 8; ++k) { BWT[(qb * 8 + k) * SX + sb] = (bf16_t)f2bf(f0[k] * wb0); BWT[(qb * 8 + k) * SX + sb + 32] = (bf16_t)f2bf(f1[k] * wb1); }
            }
        }
        { const int cn = (c + 1 < 32) ? (c + 1) : c; SCAN_ISSUE(cn); }
        lds_barrier();
        {
            const int lt = w >> 1;
#pragma unroll
            for (int q = 0; q < 2; ++q) {
                const int st = (w & 1) * 2 + q;
                f32x4 acc = (f32x4){0.f, 0.f, 0.f, 0.f};
                if (st <= lt) {
#pragma unroll
                    for (int kk = 0; kk < 4; ++kk) {
                        const bf16x8 av = *(const LAS bf16x8*)(CS + (lt * 16 + fr) * SW + kk * 32 + fq * 8);
                        const bf16x8 bv = *(const LAS bf16x8*)(BS + (st * 16 + fr) * SW + kk * 32 + fq * 8);
                        acc = mfma16(av, bv, acc);
                    }
                }
                const int s = st * 16 + fr; const float acs = ACS[s], dts = DTS[s];
#pragma unroll
                for (int j = 0; j < 4; ++j) {
                    const int l = lt * 16 + fq * 4 + j;
                    const float v = (s <= l) ? acc[j] * __expf(ACS[l] - acs) * dts : 0.f;
                    LS[l * SX + s] = (bf16_t)f2bf(v);
                }
            }
        }
        lds_barrier();
        {
            const int lt = w >> 1; float ssr[4] = {0.f, 0.f, 0.f, 0.f};
#pragma unroll
            for (int q = 0; q < 2; ++q) {
                const int pt = (w & 1) * 2 + q;
                f32x4 a1 = (f32x4){0.f, 0.f, 0.f, 0.f}, a2 = (f32x4){0.f, 0.f, 0.f, 0.f};
#pragma unroll
                for (int kk = 0; kk < 2; ++kk) {
                    const bf16x8 av = *(const LAS bf16x8*)(LS + (lt * 16 + fr) * SX + kk * 32 + fq * 8);
                    const bf16x8 bv = *(const LAS bf16x8*)(XT + (pt * 16 + fr) * SX + kk * 32 + fq * 8);
                    a1 = mfma16(av, bv, a1);
                }
#pragma unroll
                for (int kk = 0; kk < 4; ++kk) {
                    const bf16x8 av = *(const LAS bf16x8*)(CS + (lt * 16 + fr) * SW + kk * 32 + fq * 8);
                    const bf16x8 bv = *(const LAS bf16x8*)(HB + (pt * 16 + fr) * SW + kk * 32 + fq * 8);
                    a2 = mfma16(av, bv, a2);
                }
                const int p = pt * 16 + fr, l0 = lt * 16 + fq * 4;
                const u32x2 xw = *(const LAS u32x2*)(XT + p * SX + l0);
                const float xv[4] = {bflo(xw.x), bfhi(xw.x), bflo(xw.y), bfhi(xw.y)};
#pragma unroll
                for (int j = 0; j < 4; ++j) {
                    const int l = l0 + j;
                    const float y = a1[j] + __expf(ACS[l]) * a2[j] + Dh * xv[j];
                    const float z = bf1(ZS[l * SX + p]);
                    const float yv = y * silu_f(z);
                    yg[(size_t)(r0 + t0 + l) * DI + h * 64 + p] = (bf16_t)f2bf(yv);
                    ssr[j] += yv * yv;
                }
            }
#pragma unroll
            for (int j = 0; j < 4; ++j) {
                float s = ssr[j];
                s += __shfl_xor(s, 1); s += __shfl_xor(s, 2); s += __shfl_xor(s, 4); s += __shfl_xor(s, 8);
                if (fr == 0) yss[(size_t)(r0 + t0 + lt * 16 + fq * 4 + j) * 64 + h * 2 + (w & 1)] = s;
            }
        }
        {
            const int pt = w >> 1; const float dec = __expf(ACS[63]);
#pragma unroll
            for (int q = 0; q < 4; ++q) {
                const int nt = (w & 1) * 4 + q;
                hacc[q] = hacc[q] * dec;
#pragma unroll
                for (int kk = 0; kk < 2; ++kk) {
                    const bf16x8 av = *(const LAS bf16x8*)(XT + (pt * 16 + fr) * SX + kk * 32 + fq * 8);
                    const bf16x8 bv = *(const LAS bf16x8*)(BWT + (nt * 16 + fr) * SX + kk * 32 + fq * 8);
                    hacc[q] = mfma16(av, bv, hacc[q]);
                }
            }
        }
        lds_barrier();
        {
            const int pt = w >> 1;
#pragma unroll
            for (int q = 0; q < 4; ++q) {
                const int n = ((w & 1) * 4 + q) * 16 + fr;
#pragma unroll
                for (int j = 0; j < 4; ++j) HB[(pt * 16 + fq * 4 + j) * SW + n] = (bf16_t)f2bf(hacc[q][j]);
            }
        }
    }
#undef SCAN_ISSUE
    {
        float* so = a.out + O_SSMP + (size_t)(b * 32 + h) * 64 * 128;
        const int pt = w >> 1;
#pragma unroll
        for (int q = 0; q < 4; ++q) {
            const int n = ((w & 1) * 4 + q) * 16 + fr;
#pragma unroll
            for (int j = 0; j < 4; ++j) so[(size_t)(pt * 16 + fq * 4 + j) * 128 + n] = hacc[q][j];
        }
    }
#undef a
}

constexpr int LS_X = 0, LS_B = LS_X + 8 * 64 * 4, LS_C = LS_B + 8 * 128 * 4, LS_DT = LS_C + 8 * 128 * 4, LS_Y = LS_DT + 64, LS_END = LS_Y + 8 * 64 * 4;
__device__ __forceinline__ void scan_sample_all(LAS unsigned char* lds, int G, int bid) {
    const KArgs ap = kargs();
    int tid_ = threadIdx.x; asm volatile("" : "+v"(tid_));
    const int tid = tid_, lane = tid & 63, w = tid >> 6;
    unsigned char* ws = ap->ws;
    const bf16_t* proj = (const bf16_t*)(ws + WS_R1);
    const float* dtraw = (const float*)(ws + WS_DT);
    bf16_t* yg = (bf16_t*)(ws + WS_YG); float* yss = (float*)(ws + WS_YSS);
    LAS float* XS = (LAS float*)(lds + LS_X); LAS float* BSs = (LAS float*)(lds + LS_B); LAS float* CSs = (LAS float*)(lds + LS_C);
    LAS float* DTs = (LAS float*)(lds + LS_DT); LAS float* YS = (LAS float*)(lds + LS_Y);
    const int p = tid >> 3, nb = (tid & 7) * 16;
    const bool conv_t = tid < 320, dt_t = (tid >= 320 && tid < 328);
    const int crel = (tid < 64) ? tid : (tid < 192) ? (tid - 64) : (tid - 192);
    LAS float* cdst = (tid < 64) ? (XS + tid) : (tid < 192) ? (BSs + (tid - 64)) : (CSs + (tid - 192));
    const int dstride = (tid < 64) ? 64 : 128;
    int it = bid; if (it >= 4096) return;
    f32x4 hn[4]; float cin[11], wn[5], dtn = 0.f, zn;
#pragma unroll
    for (int i = 0; i < 11; ++i) cin[i] = 0.f;
#pragma unroll
    for (int i = 0; i < 5; ++i) wn[i] = 0.f;
#define SAMPLE_ISSUE(it_) do { const int b_ = (it_) >> 5, h_ = (it_) & 31, g_ = h_ >> 2, r0_ = MP + b_ * 8; \
        const float* hin_ = ap->in[2] + ((size_t)(b_ * 32 + h_) * 64 + p) * 128 + nb; \
        _Pragma("unroll") for (int i_ = 0; i_ < 4; ++i_) hn[i_] = *(const f32x4*)(hin_ + 4 * i_); \
        if (conv_t) { const int col_ = (tid < 64) ? (2048 + h_ * 64 + crel) : (tid < 192) ? (4096 + g_ * 128 + crel) : (5120 + g_ * 128 + crel); const int ch_ = col_ - 2048; \
            const float* cwp_ = ap->in[11] + ch_; wn[0] = cwp_[0]; wn[1] = cwp_[4096]; wn[2] = cwp_[8192]; wn[3] = cwp_[12288]; wn[4] = ap->in[12][ch_]; \
            const float* cs_ = ap->in[3] + (size_t)b_ * 3 * 4096 + ch_; cin[0] = cs_[0]; cin[1] = cs_[4096]; cin[2] = cs_[8192]; \
            _Pragma("unroll") for (int t_ = 0; t_ < 8; ++t_) cin[3 + t_] = bf1(proj[(size_t)(r0_ + t_) * NPROJ + col_]); } \
        else if (dt_t) { dtn = dtraw[(size_t)(r0_ + tid - 320) * 32 + h_] + ap->in[13][h_]; } \
        zn = bf1(proj[(size_t)(r0_ + w) * NPROJ + h_ * 64 + lane]); } while (0)
    SAMPLE_ISSUE(it);
#pragma unroll 1
    for (; it < 4096; it += G) {
        const int b = it >> 5, h = it & 31, r0 = MP + b * 8;
        const float Ah = -__expf(ap->in[14][h]), Dh = ap->in[15][h];
        f32x4 hs[4];
#pragma unroll
        for (int i = 0; i < 4; ++i) hs[i] = hn[i];
        const float zc = zn;
        lds_barrier();
        if (conv_t) {
            float q0 = cin[0], q1 = cin[1], q2 = cin[2];
#pragma unroll
            for (int t = 0; t < 8; ++t) {
                const float cur = cin[3 + t];
                const float v = wn[4] + wn[0] * q0 + wn[1] * q1 + wn[2] * q2 + wn[3] * cur;
                cdst[t * dstride] = silu_f(v);
                q0 = q1; q1 = q2; q2 = cur;
            }
        } else if (dt_t) {
            DTs[tid - 320] = (dtn > 20.f) ? dtn : log1pf(__expf(dtn));
        }
        { const int itn = (it + G < 4096) ? (it + G) : it; SAMPLE_ISSUE(itn); }
        lds_barrier();
#pragma unroll
        for (int t = 0; t < 8; ++t) {
            const float dt = DTs[t], dec = __expf(dt * Ah), xv = XS[t * 64 + p] * dt;
            float yp = 0.f;
#pragma unroll
            for (int i = 0; i < 4; ++i) {
                const f32x4 bv = *(const LAS f32x4*)(BSs + t * 128 + nb + 4 * i);
                const f32x4 cv = *(const LAS f32x4*)(CSs + t * 128 + nb + 4 * i);
                hs[i] = hs[i] * dec + bv * xv;
                yp += (hs[i][0] * cv[0] + hs[i][1] * cv[1]) + (hs[i][2] * cv[2] + hs[i][3] * cv[3]);
            }
            yp += __shfl_xor(yp, 1); yp += __shfl_xor(yp, 2); yp += __shfl_xor(yp, 4);
            if ((tid & 7) == 0) YS[t * 64 + p] = yp;
        }
        {
            float* so = ap->out + O_SSMS + ((size_t)(b * 32 + h) * 64 + p) * 128 + nb;
#pragma unroll
            for (int i = 0; i < 4; ++i) *(f32x4*)(so + 4 * i) = hs[i];
        }
        lds_barrier();
        {
            const int t = w;
            const float y = YS[t * 64 + lane] + Dh * XS[t * 64 + lane];
            const float yv = y * silu_f(zc);
            yg[(size_t)(r0 + t) * DI + h * 64 + lane] = (bf16_t)f2bf(yv);
            const float s = wave_sum(yv * yv);
            if (lane < 2) yss[(size_t)(r0 + t) * 64 + h * 2 + lane] = (lane == 0) ? s : 0.f;
        }
    }
#undef SAMPLE_ISSUE
}

__device__ __forceinline__ void phase_scan(LAS unsigned char* lds, int G, int bid) {
    for (int it = bid; it < 256; it += G) { __syncthreads(); scan_prompt_item(lds, it >> 5, it & 31); }
    __syncthreads();
    scan_sample_all(lds, G, bid);
}

__device__ __forceinline__ void phase_ynorm(int G, int bid) {
    const KArgs ap = kargs();
#define a (*ap)
    bf16_t* yg = (bf16_t*)(a.ws + WS_YG); const float* yss = (const float*)(a.ws + WS_YSS);
    const int total = MT * 256;
    int tid_ = threadIdx.x; asm volatile("" : "+v"(tid_));
    for (int idx = bid * NTHR + tid_; idx < total; idx += G * NTHR) {
        const int r = idx >> 8, cc = idx & 255, g = cc >> 5;
        const f32x4 s0 = *(const f32x4*)(yss + (size_t)r * 64 + g * 8), s1 = *(const f32x4*)(yss + (size_t)r * 64 + g * 8 + 4);
        const float ss = ((s0[0] + s0[1]) + (s0[2] + s0[3])) + ((s1[0] + s1[1]) + (s1[2] + s1[3]));
        const float rs = rsqrtf(ss * (1.0f / 256.0f) + EPS);
        u32x4* ptr = (u32x4*)(yg + (size_t)r * DI + cc * 8);
        const u32x4 v = *ptr; float f[8]; unpack8(v, f);
        u32x4 o; o.x = cvt_pk_bf16(f[0] * rs, f[1] * rs); o.y = cvt_pk_bf16(f[2] * rs, f[3] * rs); o.z = cvt_pk_bf16(f[4] * rs, f[5] * rs); o.w = cvt_pk_bf16(f[6] * rs, f[7] * rs);
        *ptr = o;
    }
#undef a
}

__device__ __forceinline__ void phase_poolstats(int G, int bid) {
    const KArgs ap = kargs();
#define a (*ap)
    const bf16_t* ub = (const bf16_t*)(a.ws + WS_R1);
    bf16_t* mixed = (bf16_t*)(a.ws + WS_R1 + (size_t)MT * DM * 2);
    const float* spool = a.in[4];
    const int total = MT * 128;
    int tid_ = threadIdx.x; asm volatile("" : "+v"(tid_));
    for (int idx = bid * NTHR + tid_; idx < total; idx += G * NTHR) {
        const int r = idx >> 7, cc = idx & 127, c0 = cc * 8, k = cc >> 5, wlen = 2 << k;
        float sum[8] = {0.f, 0.f, 0.f, 0.f, 0.f, 0.f, 0.f, 0.f}; float own[8]; float cnt;
        {
            const u32x4 v = *(const u32x4*)(ub + (size_t)r * DM + c0); unpack8(v, own);
        }
        if (r < MP) {
            const int t = r & 2047; const int n = (t + 1 < wlen) ? (t + 1) : wlen; cnt = (float)n;
            for (int i = 0; i < n; ++i) { const u32x4 v = *(const u32x4*)(ub + (size_t)(r - i) * DM + c0); float f[8]; unpack8(v, f);
#pragma unroll
                for (int e = 0; e < 8; ++e) sum[e] += f[e]; }
        } else {
            const int q = r - MP, bb = q >> 3, t = q & 7; cnt = (float)wlen;
            for (int i = 0; i < wlen; ++i) {
                const int e_ = 15 + t - i;
                if (e_ >= 15) { const u32x4 v = *(const u32x4*)(ub + (size_t)(MP + bb * 8 + (e_ - 15)) * DM + c0); float f[8]; unpack8(v, f);
#pragma unroll
                    for (int e = 0; e < 8; ++e) sum[e] += f[e]; }
                else { const float* sp = spool + ((size_t)bb * 15 + e_) * 1024 + c0; const f32x4 v0 = *(const f32x4*)sp, v1 = *(const f32x4*)(sp + 4);
#pragma unroll
                    for (int e = 0; e < 4; ++e) { sum[e] += v0[e]; sum[4 + e] += v1[e]; } }
            }
        }
        const float inv = 1.0f / cnt;
        u32x4 o; o.x = cvt_pk_bf16(sum[0] * inv - own[0], sum[1] * inv - own[1]); o.y = cvt_pk_bf16(sum[2] * inv - own[2], sum[3] * inv - own[3]);
        o.z = cvt_pk_bf16(sum[4] * inv - own[4], sum[5] * inv - own[5]); o.w = cvt_pk_bf16(sum[6] * inv - own[6], sum[7] * inv - own[7]);
        *(u32x4*)(mixed + (size_t)r * DM + c0) = o;
    }
    float* pools = a.out + O_POOLS;
    const int tot2 = 128 * 7 * 256;
    for (int idx = bid * NTHR + tid_; idx < tot2; idx += G * NTHR) {
        const int c4 = idx & 255, j = (idx >> 8) % 7, bb = idx / (7 * 256);
        *(f32x4*)(pools + ((size_t)bb * 15 + j) * 1024 + c4 * 4) = *(const f32x4*)(spool + ((size_t)bb * 15 + 8 + j) * 1024 + c4 * 4);
    }
#undef a
}

__device__ __forceinline__ void phase_final(int G, int bid) {
    const KArgs ap = kargs();
#define a (*ap)
    const float* xres = (const float*)(a.ws + WS_XRES); const float* ssq = (const float*)(a.ws + WS_SSQ); const float* gn = a.in[22];
    float* y = a.out + O_Y;
    const int total = MT * 256;
    int tid_ = threadIdx.x; asm volatile("" : "+v"(tid_));
    for (int idx = bid * NTHR + tid_; idx < total; idx += G * NTHR) {
        const int r = idx >> 8, c4 = idx & 255;
        const float* sp = ssq + (size_t)r * 16;
        const f32x4 q0 = *(const f32x4*)sp, q1 = *(const f32x4*)(sp + 4), q2 = *(const f32x4*)(sp + 8), q3 = *(const f32x4*)(sp + 12);
        const float ss = (((q0[0] + q0[1]) + (q0[2] + q0[3])) + ((q1[0] + q1[1]) + (q1[2] + q1[3]))) + (((q2[0] + q2[1]) + (q2[2] + q2[3])) + ((q3[0] + q3[1]) + (q3[2] + q3[3])));
        const float rs = rsqrtf(ss * (1.0f / 1024.0f) + EPS);
        const f32x4 v = *(const f32x4*)(xres + (size_t)r * DM + c4 * 4), gg = *(const f32x4*)(gn + c4 * 4);
        *(f32x4*)(y + (size_t)r * DM + c4 * 4) = v * rs * gg;
    }
#undef a
}

__device__ __forceinline__ void run_ffn_up(LAS unsigned char* lds, int f, int G, int bid) {
    const KArgs ap = kargs(); unsigned char* ws = ap->ws;
    EpiSwiGLU e; e.act = (bf16_t*)(ws + WS_R1); e.ssq = (const float*)(ws + WS_SSQ);
    Order S; S.init(MT / BM, 5632 / BM, G, bid);
    gemm_phase(lds, (const bf16_t*)(ws + WS_XB), DM, 0, (const bf16_t*)(ws + WS_WGU) + (size_t)f * 5632 * 1024, DM, S, e);
}
__device__ __forceinline__ void run_resid(LAS unsigned char* lds, int which, int f, int G, int bid) {
    const KArgs ap = kargs(); unsigned char* ws = ap->ws;
    float* xres = (float*)(ws + WS_XRES);
    EpiResid e; e.rin0 = xres; e.rin1 = xres; e.rout = xres; e.xb = (bf16_t*)(ws + WS_XB); e.ssq = (float*)(ws + WS_SSQ); e.scale = (which == 0) ? 0.5f : 1.0f;
    if (which == 0 && f == 0) { e.rin0 = ap->in[0]; e.rin1 = ap->in[1] - (size_t)MP * DM; }
    const bf16_t* A; const bf16_t* Bt; int K;
    if (which == 0) { A = (const bf16_t*)(ws + WS_R1); Bt = (const bf16_t*)(ws + WS_WD) + (size_t)f * 1024 * 2816; K = FF; }
    else if (which == 1) { A = (const bf16_t*)(ws + WS_YG); Bt = (const bf16_t*)(ws + WS_WOUT); K = DI; }
    else { A = (const bf16_t*)(ws + WS_R1) + (size_t)2 * MT * DM; Bt = (const bf16_t*)(ws + WS_WPOUT); K = DM; }
    Order S; S.init(MT / BM, DM / BM, G, bid);
    gemm_phase(lds, A, K, 0, Bt, K, S, e);
}
__device__ __forceinline__ void run_proj(LAS unsigned char* lds, int G, int bid) {
    const KArgs ap = kargs(); unsigned char* ws = ap->ws;
    EpiProj e; e.proj = (bf16_t*)(ws + WS_R1); e.dtraw = (float*)(ws + WS_DT); e.ssq = (const float*)(ws + WS_SSQ); e.convp = ap->out + O_CONVP; e.convs = ap->out + O_CONVS; e.halo = (bf16_t*)(ws + WS_HALO);
    Order S; S.init(MT / BM, NINP / BM, G, bid);
    gemm_phase(lds, (const bf16_t*)(ws + WS_XB), DM, 0, (const bf16_t*)(ws + WS_WIN), DM, S, e);
}
__device__ __forceinline__ void run_poolin(LAS unsigned char* lds, int G, int bid) {
    const KArgs ap = kargs(); unsigned char* ws = ap->ws;
    EpiPoolIn e; e.ub = (bf16_t*)(ws + WS_R1); e.ssq = (const float*)(ws + WS_SSQ); e.poolp = ap->out + O_POOLP; e.pools = ap->out + O_POOLS;
    Order S; S.init(MT / BM, DM / BM, G, bid);
    gemm_phase(lds, (const bf16_t*)(ws + WS_XB), DM, 0, (const bf16_t*)(ws + WS_WPIN), DM, S, e);
}
__device__ __forceinline__ void run_poolgrp(LAS unsigned char* lds, int G, int bid) {
    const KArgs ap = kargs(); unsigned char* ws = ap->ws;
    bf16_t* ub = (bf16_t*)(ws + WS_R1);
    EpiBf16 e; e.O = ub + (size_t)2 * MT * DM; e.ldc = DM;
    Order S; S.init(MT / BM, DM / BM, G, bid);
    gemm_phase(lds, ub + (size_t)MT * DM, DM, 256, (const bf16_t*)(ws + WS_WPG), 256, S, e);
}

__global__ void __launch_bounds__(NTHR, 2) fwd_megakernel(Args a_unused) {
    extern __shared__ __attribute__((aligned(16))) unsigned char lds_raw[];
    LAS unsigned char* lds = (LAS unsigned char*)lds_raw;
    cg::grid_group grid = cg::this_grid();
    const int G = gridDim.x, bid = blockIdx.x;

    phase_prep(lds, G, bid);
    grid.sync();
#pragma unroll 1
    for (int f = 0; f < 4; ++f) {
        run_ffn_up(lds, f, G, bid);
        grid.sync();
        run_resid(lds, 0, f, G, bid);
        grid.sync();
        if (f == 0) {
            run_proj(lds, G, bid);
            grid.sync();
            phase_conv(G, bid);
            grid.sync();
            phase_scan(lds, G, bid);
            grid.sync();
            phase_ynorm(G, bid);
            grid.sync();
            run_resid(lds, 1, f, G, bid);
            grid.sync();
        }
        if (f == 2) {
            run_poolin(lds, G, bid);
            grid.sync();
            phase_poolstats(G, bid);
            grid.sync();
            run_poolgrp(lds, G, bid);
            grid.sync();
            run_resid(lds, 2, f, G, bid);
            grid.sync();
        }
    }
    phase_final(G, bid);
}

extern "C" void kernel_launch(void* const* d_in, const int* in_sizes, int n_in, void* d_out, int out_size, void* d_ws, size_t ws_size, hipStream_t stream) {
    static int grid_blocks = 0;
    if (grid_blocks == 0) {
        if (n_in != 23 || ws_size < WS_END) { fprintf(stderr, "kernel_launch: need 23 inputs and %zu B of workspace (got %d, %zu)\n", (size_t)WS_END, n_in, ws_size); grid_blocks = -1; return; }
        int dev = 0, cus = 0, per_cu = 0;
        (void)hipGetDevice(&dev);
        (void)hipDeviceGetAttribute(&cus, hipDeviceAttributeMultiprocessorCount, dev);
        if (hipFuncSetAttribute((const void*)fwd_megakernel, hipFuncAttributeMaxDynamicSharedMemorySize, LDS_BYTES) != hipSuccess) { fprintf(stderr, "kernel_launch: hipFuncSetAttribute failed\n"); }
        if (hipOccupancyMaxActiveBlocksPerMultiprocessor(&per_cu, (const void*)fwd_megakernel, NTHR, LDS_BYTES) != hipSuccess || per_cu < 1) { fprintf(stderr, "kernel_launch: occupancy query gave %d\n", per_cu); per_cu = 1; }
        (void)hipGetLastError();
        if (per_cu > 1) per_cu = 1;
        grid_blocks = cus * per_cu;
    }
    if (grid_blocks < 0) return;
    Args a{};
    for (int i = 0; i < 23; ++i) a.in[i] = (const float*)d_in[i];
    a.out = (float*)d_out; a.ws = (unsigned char*)d_ws;
    void* args[] = {&a};
    hipError_t e = hipLaunchCooperativeKernel((const void*)fwd_megakernel, dim3(grid_blocks), dim3(NTHR), args, LDS_BYTES, stream);
    if (e != hipSuccess) fprintf(stderr, "cooperative launch failed: %s (grid %d)\n", hipGetErrorString(e), grid_blocks);
}
```
